# Optimizing an MI355X kernel written in HIP

```python
import math
import jax, jax.numpy as jnp
from jax import lax
import numpy as np

D_MODEL = 1024
BATCH = 4
SEQ = 4096
DEPTH = 1

N_ATTN_HEADS = 4
ATTN_HEAD_DIM = 64
ATTN_V_DIM = 2 * ATTN_HEAD_DIM
ATTN_QK_WIDTH = N_ATTN_HEADS * 2 * ATTN_HEAD_DIM
ATTN_WIDTH = N_ATTN_HEADS * ATTN_V_DIM
ROPE_THETA = 10000.0
Q_BLOCK = 128
CONV_WIDTH = 512
CONV_SIZE = 3
PEER_HEADS = 8
PEER_N_KEYS = 128
PEER_N_EXPERTS = PEER_N_KEYS * PEER_N_KEYS
PEER_HALF_DIM = 128
PEER_TOPK = 16
TOKEN_CHUNK = 128
NORM_EPS = 1e-6
IN_SIZES = (ATTN_QK_WIDTH, ATTN_QK_WIDTH, ATTN_WIDTH, CONV_WIDTH, CONV_WIDTH, CONV_WIDTH, D_MODEL, D_MODEL)
IN_WIDTH = 2 * ATTN_QK_WIDTH + ATTN_WIDTH + 3 * CONV_WIDTH + 2 * D_MODEL

kernel_name = "hybrid_diffattn_shortconv_peer_block"


def rmsnorm(x, w):
    xf = x.astype(jnp.float32)
    y = xf * lax.rsqrt(jnp.mean(xf * xf, axis=-1, keepdims=True) + NORM_EPS)
    return (y * w.astype(jnp.float32)).astype(x.dtype)


def rope_tables(seq, dim):
    inv_freq = 1.0 / (ROPE_THETA ** (jnp.arange(0, dim, 2, dtype=jnp.float32) / dim))
    ang = jnp.arange(seq, dtype=jnp.float32)[:, None] * inv_freq[None, :]
    ang = jnp.concatenate([ang, ang], axis=-1)
    return jnp.cos(ang), jnp.sin(ang)


def apply_rope(t, cos, sin):
    half = t.shape[-1] // 2
    t1, t2 = t[..., :half], t[..., half:]
    rot = jnp.concatenate([-t2, t1], axis=-1)
    c = cos[None, :, None, None, :].astype(t.dtype)
    s = sin[None, :, None, None, :].astype(t.dtype)
    return t * c + rot * s


def diff_attention(q, k, v, lam):
    b, s, h, _, dh = q.shape
    scale = 1.0 / math.sqrt(dh)
    nb = s // Q_BLOCK
    qb = jnp.moveaxis(q.reshape(b, nb, Q_BLOCK, h, 2, dh), 1, 0)

    def block(qblk):
        sc = jnp.einsum('bqhmd,bkhmd->bhmqk', qblk, k).astype(jnp.float32) * scale
        p = jax.nn.softmax(sc, axis=-1)
        diff = p[:, :, 0] - lam * p[:, :, 1]
        return jnp.einsum('bhqk,bkhe->bqhe', diff.astype(v.dtype), v)

    out = lax.map(block, qb)
    return jnp.moveaxis(out, 0, 1).reshape(b, s, h, v.shape[-1])


def short_conv(z, conv_w):
    c = z.shape[-1]
    return lax.conv_general_dilated(
        z, conv_w.reshape(CONV_SIZE, 1, c).astype(z.dtype), window_strides=(1,),
        padding=((CONV_SIZE // 2, CONV_SIZE // 2),),
        dimension_numbers=('NWC', 'WIO', 'NWC'), feature_group_count=c)


def mixer_block(xn, w_in, lq1, lk1, lq2, lk2, subln_w, conv_w, w_pa, w_pb, w_o, cos, sin, lambda_init):
    b, s, _ = xn.shape
    proj = xn @ w_in
    offs, acc = [], 0
    for sz in IN_SIZES[:-1]:
        acc += sz
        offs.append(acc)
    q, k, v, bg, cg, xc, ga, gb = jnp.split(proj, offs, axis=-1)

    q = apply_rope(q.reshape(b, s, N_ATTN_HEADS, 2, ATTN_HEAD_DIM), cos, sin)
    k = apply_rope(k.reshape(b, s, N_ATTN_HEADS, 2, ATTN_HEAD_DIM), cos, sin)
    v = v.reshape(b, s, N_ATTN_HEADS, ATTN_V_DIM)
    lam = (jnp.exp(jnp.sum(lq1.astype(jnp.float32) * lk1.astype(jnp.float32)))
           - jnp.exp(jnp.sum(lq2.astype(jnp.float32) * lk2.astype(jnp.float32))) + lambda_init)
    attn = diff_attention(q, k, v, lam)
    attn = rmsnorm(attn, subln_w) * (1.0 - lambda_init)
    y_attn = attn.reshape(b, s, ATTN_WIDTH) @ w_pa

    y_conv = (bg * short_conv(cg * xc, conv_w)) @ w_pb

    merged = jax.nn.sigmoid(ga) * y_attn + jax.nn.sigmoid(gb) * y_conv
    return merged @ w_o


def peer_ffn(hn, w_query, sub_keys, expert_u, expert_v):
    b, s, d = hn.shape
    chunks = hn.reshape(-1, TOKEN_CHUNK, d)

    def chunk(xc):
        c = xc.shape[0]
        q = (xc @ w_query).reshape(c, PEER_HEADS, 2, PEER_HALF_DIM)
        sc = jnp.einsum('chpd,hpnd->chpn', q, sub_keys).astype(jnp.float32)
        s1, i1 = lax.top_k(sc[:, :, 0], PEER_TOPK)
        s2, i2 = lax.top_k(sc[:, :, 1], PEER_TOPK)
        cand = (s1[..., :, None] + s2[..., None, :]).reshape(c, PEER_HEADS, PEER_TOPK * PEER_TOPK)
        cidx = (i1[..., :, None] * PEER_N_KEYS + i2[..., None, :]).reshape(c, PEER_HEADS, PEER_TOPK * PEER_TOPK)
        top, pos = lax.top_k(cand, PEER_TOPK)
        eidx = jnp.take_along_axis(cidx, pos, axis=-1)
        g = jax.nn.softmax(top, axis=-1)
        u = expert_u[eidx]
        a = jax.nn.gelu(jnp.einsum('chkd,cd->chk', u, xc), approximate=False)
        vv = expert_v[eidx]
        return jnp.einsum('chk,chkd->cd', (g.astype(a.dtype) * a), vv)

    out = lax.map(chunk, chunks)
    return out.reshape(b, s, d)


def setup_inputs(seed: int = 0) -> dict:
    key = jax.random.key(seed)
    ks = jax.random.split(key, 20)
    f32 = jnp.float32
    n = lambda k, shape, sc: jax.random.normal(k, shape, f32) * sc
    return {
        "x": n(ks[0], (BATCH, SEQ, D_MODEL), 1.0),
        "attn_norm_w": 1.0 + n(ks[1], (DEPTH, D_MODEL), 0.01),
        "w_in": n(ks[2], (DEPTH, D_MODEL, IN_WIDTH), D_MODEL ** -0.5),
        "lambda_q1": n(ks[3], (DEPTH, ATTN_HEAD_DIM), 0.1),
        "lambda_k1": n(ks[4], (DEPTH, ATTN_HEAD_DIM), 0.1),
        "lambda_q2": n(ks[5], (DEPTH, ATTN_HEAD_DIM), 0.1),
        "lambda_k2": n(ks[6], (DEPTH, ATTN_HEAD_DIM), 0.1),
        "subln_w": 1.0 + n(ks[7], (DEPTH, ATTN_V_DIM), 0.01),
        "conv_w": n(ks[8], (DEPTH, CONV_SIZE, CONV_WIDTH), CONV_SIZE ** -0.5),
        "w_proj_attn": n(ks[9], (DEPTH, ATTN_WIDTH, D_MODEL), ATTN_WIDTH ** -0.5),
        "w_proj_conv": n(ks[10], (DEPTH, CONV_WIDTH, D_MODEL), CONV_WIDTH ** -0.5),
        "w_out": n(ks[11], (DEPTH, D_MODEL, D_MODEL), D_MODEL ** -0.5),
        "ffn_norm_w": 1.0 + n(ks[12], (DEPTH, D_MODEL), 0.01),
        "w_query": n(ks[13], (DEPTH, D_MODEL, PEER_HEADS * 2 * PEER_HALF_DIM), D_MODEL ** -0.5),
        "sub_keys": n(ks[14], (DEPTH, PEER_HEADS, 2, PEER_N_KEYS, PEER_HALF_DIM), PEER_HALF_DIM ** -0.5),
        "expert_u": n(ks[15], (DEPTH, PEER_N_EXPERTS, D_MODEL), D_MODEL ** -0.5),
        "expert_v": n(ks[16], (DEPTH, PEER_N_EXPERTS, D_MODEL), PEER_HEADS ** -0.5),
        "final_norm_w": 1.0 + n(ks[17], (D_MODEL,), 0.01),
    }


def reference(x, attn_norm_w, w_in, lambda_q1, lambda_k1, lambda_q2, lambda_k2, subln_w, conv_w,
              w_proj_attn, w_proj_conv, w_out, ffn_norm_w, w_query, sub_keys, expert_u, expert_v,
              final_norm_w):
    cos, sin = rope_tables(x.shape[1], ATTN_HEAD_DIM)
    h = x
    for l in range(DEPTH):
        lambda_init = 0.8 - 0.6 * math.exp(-0.3 * l)
        xn = rmsnorm(h, attn_norm_w[l])
        h = h + mixer_block(xn, w_in[l], lambda_q1[l], lambda_k1[l], lambda_q2[l], lambda_k2[l],
                            subln_w[l], conv_w[l], w_proj_attn[l], w_proj_conv[l], w_out[l],
                            cos, sin, lambda_init)
        hn = rmsnorm(h, ffn_norm_w[l])
        h = h + peer_ffn(hn, w_query[l], sub_keys[l], expert_u[l], expert_v[l])
    return rmsnorm(h, final_norm_w)
```

```cpp
#include <hip/hip_runtime.h>
#include <cstdint>
#include <cstdio>

constexpr int NB = 4, SEQ = 4096, DM = 1024, NTOK = NB * SEQ;
constexpr int NH = 4, DH = 64, DV = 128, QKW = 512, AW = 512, CW = 512;
constexpr int INW = 5120;
constexpr int PH = 8, NKEY = 128, PHD = 128, TOPK = 16, NEXP = 16384, QPW = 2048;
constexpr float EPS = 1e-6f;
constexpr float LAMBDA_INIT = 0.2f;
constexpr float C2 = 0.125f * 1.4426950408889634f;

constexpr size_t MiB = 1u << 20;
constexpr size_t WS_CTL = 0, CTL_BYTES = 1 * MiB;
constexpr size_t WS_WIN = 1 * MiB;
constexpr size_t WS_WPA = 11 * MiB;
constexpr size_t WS_WPB = 12 * MiB;
constexpr size_t WS_WO = 13 * MiB;
constexpr size_t WS_WQ = 15 * MiB;
constexpr size_t WS_KEYS = 19 * MiB;
constexpr size_t WS_ROPE = 20 * MiB;
constexpr size_t WS_EU = 21 * MiB;
constexpr size_t WS_EV = 53 * MiB;
constexpr size_t WS_XN = 85 * MiB;
constexpr size_t WS_ATTN = 85 * MiB;
constexpr size_t WS_CF = 101 * MiB;
constexpr size_t WS_HN = 85 * MiB;
constexpr size_t WS_Q = 117 * MiB;
constexpr size_t WS_KV = 133 * MiB;
constexpr size_t WS_BG = 165 * MiB, WS_CG = 181 * MiB, WS_XC = 197 * MiB;
constexpr size_t WS_MG = 117 * MiB;
constexpr size_t WS_TMP = 149 * MiB;
constexpr size_t WS_H = 181 * MiB;
constexpr size_t WS_QP = 117 * MiB;
constexpr size_t WS_SEL = 245 * MiB;
constexpr size_t WS_END = 256 * MiB;

typedef unsigned short bf16;
typedef float f32x4 __attribute__((ext_vector_type(4)));
typedef float f32x16 __attribute__((ext_vector_type(16)));
typedef float f32x2 __attribute__((ext_vector_type(2)));
typedef unsigned u32x4 __attribute__((ext_vector_type(4)));
typedef unsigned u32x2 __attribute__((ext_vector_type(2)));
typedef short bf16x8 __attribute__((ext_vector_type(8)));
#define LAS __attribute__((address_space(3)))

__host__ __device__ __forceinline__ unsigned f2bf(float f) { unsigned u = __builtin_bit_cast(unsigned, f); return (u + 0x7fffu + ((u >> 16) & 1u)) >> 16; }
__host__ __device__ __forceinline__ unsigned pk2(float lo, float hi) { return f2bf(lo) | (f2bf(hi) << 16); }
__host__ __device__ __forceinline__ float bf2f(unsigned h) { return __builtin_bit_cast(float, (h & 0xffffu) << 16); }
__device__ __forceinline__ float bflo(unsigned w) { return __builtin_bit_cast(float, w << 16); }
__device__ __forceinline__ float bfhi(unsigned w) { return __builtin_bit_cast(float, w & 0xffff0000u); }

__host__ __device__ __forceinline__ size_t kv_tile_off(int b, int h, int tile) { return (size_t)((b * NH + h) * 64 + tile) * 32768; }
__host__ __device__ __forceinline__ int k_img_off(int m, int kvr, int p) { return m * 8192 + (p >> 3) * 1024 + kvr * 16 + (p & 7) * 2; }
__host__ __device__ __forceinline__ int v_img_off(int kvr, int e) { return 16384 + (e >> 5) * 4096 + (kvr >> 4) * 1024 + (kvr & 15) * 64 + (e & 31) * 2; }
struct Ptrs {
    const float *x, *attn_norm_w, *w_in, *lq1, *lk1, *lq2, *lk2, *subln_w, *conv_w, *w_pa, *w_pb, *w_o, *ffn_norm_w, *w_query, *sub_keys, *expert_u, *expert_v, *final_norm_w;
    float* out; unsigned char* ws;
};
__device__ __forceinline__ float wave_sum(float v) {
#pragma unroll
    for (int o = 1; o < 64; o <<= 1) v += __shfl_xor(v, o);
    return v;
}
__device__ __forceinline__ int rope_row(int c) { if (c < 1024) { const int g = c >> 6, d = c & 63; return (g << 6) + 2 * (d & 31) + (d >> 5); } return c; }
template <int MAP>
__device__ __forceinline__ void p0_transpose_item(const float* W, int K, int N, bf16* WT, LAS float* scr, int item, int lane) {
    const int nblk = N / 32, kb = item / nblk, nb = item % nblk, k0 = 64 * kb, n0 = 32 * nb;
#pragma unroll 8
    for (int i = 0; i < 32; ++i) { const int kk = 2 * i + (lane >> 5); scr[kk * 33 + (lane & 31)] = W[(size_t)(k0 + kk) * N + n0 + (lane & 31)]; }
    asm volatile("s_waitcnt lgkmcnt(0)" ::: "memory");
    const int c = lane & 7;
#pragma unroll
    for (int j = 0; j < 4; ++j) { const int n = (lane >> 3) + 8 * j; const LAS float* s = scr + (8 * c) * 33 + n;
        u32x4 o; o.x = pk2(s[0 * 33], s[1 * 33]); o.y = pk2(s[2 * 33], s[3 * 33]); o.z = pk2(s[4 * 33], s[5 * 33]); o.w = pk2(s[6 * 33], s[7 * 33]);
        const int drow = MAP ? rope_row(n0 + n) : (n0 + n);
        *(u32x4*)(WT + (size_t)drow * K + k0 + 8 * c) = o; }
    asm volatile("s_waitcnt lgkmcnt(0)" ::: "memory");
}
__device__ __forceinline__ void p0_cvt_chunk(const float* src, bf16* dst, int lane) {
    const f32x4 a = *(const f32x4*)(src + lane * 8), b = *(const f32x4*)(src + lane * 8 + 4);
    u32x4 o; o.x = pk2(a.x, a.y); o.y = pk2(a.z, a.w); o.z = pk2(b.x, b.y); o.w = pk2(b.z, b.w);
    *(u32x4*)(dst + lane * 8) = o;
}
__device__ __forceinline__ void rms_row_to_bf16(const float* xrow, const float* w, bf16* orow, int lane) {
    const f32x4* xr = (const f32x4*)xrow + lane; const f32x4* wr = (const f32x4*)w + lane;
    f32x4 v[4]; float s = 0.f;
#pragma unroll
    for (int j = 0; j < 4; ++j) { v[j] = xr[64 * j]; s += (v[j].x * v[j].x + v[j].y * v[j].y) + (v[j].z * v[j].z + v[j].w * v[j].w); }
    const float rstd = rsqrtf(wave_sum(s) * (1.f / DM) + EPS);
    unsigned long long* o8 = (unsigned long long*)orow + lane;
#pragma unroll
    for (int j = 0; j < 4; ++j) { const f32x4 ww = wr[64 * j];
        o8[64 * j] = (unsigned long long)pk2(v[j].x * rstd * ww.x, v[j].y * rstd * ww.y) | ((unsigned long long)pk2(v[j].z * rstd * ww.z, v[j].w * rstd * ww.w) << 32); }
}
__device__ __forceinline__ void p0_prologue(const Ptrs& P, int gw, int NGW, int lane, LAS float* scr) {
    unsigned char* ws = P.ws;
    bf16* WIN = (bf16*)(ws + WS_WIN); bf16* WPA = (bf16*)(ws + WS_WPA); bf16* WPB = (bf16*)(ws + WS_WPB); bf16* WO = (bf16*)(ws + WS_WO); bf16* WQ = (bf16*)(ws + WS_WQ);
    constexpr int I_IN = (DM / 64) * (INW / 32), I_PA = (AW / 64) * (DM / 32), I_PB = (CW / 64) * (DM / 32), I_O = (DM / 64) * (DM / 32), I_Q = (DM / 64) * (QPW / 32);
    constexpr int NITEMS = I_IN + I_PA + I_PB + I_O + I_Q;
    for (int it = gw; it < NITEMS; it += NGW) {
        int r = it;
        if (r < I_IN) { p0_transpose_item<1>(P.w_in, DM, INW, WIN, scr, r, lane); continue; } r -= I_IN;
        if (r < I_PA) { p0_transpose_item<0>(P.w_pa, AW, DM, WPA, scr, r, lane); continue; } r -= I_PA;
        if (r < I_PB) { p0_transpose_item<0>(P.w_pb, CW, DM, WPB, scr, r, lane); continue; } r -= I_PB;
        if (r < I_O) { p0_transpose_item<0>(P.w_o, DM, DM, WO, scr, r, lane); continue; } r -= I_O;
        p0_transpose_item<0>(P.w_query, DM, QPW, WQ, scr, r, lane);
    }
    constexpr int C_K = (PH * 2 * NKEY * PHD) / 512, C_E = (NEXP * DM) / 512;
    for (int it = gw; it < C_K + 2 * C_E; it += NGW) {
        int r = it;
        if (r < C_K) { p0_cvt_chunk(P.sub_keys + (size_t)r * 512, (bf16*)(ws + WS_KEYS) + (size_t)r * 512, lane); continue; } r -= C_K;
        if (r < C_E) { p0_cvt_chunk(P.expert_u + (size_t)r * 512, (bf16*)(ws + WS_EU) + (size_t)r * 512, lane); continue; } r -= C_E;
        p0_cvt_chunk(P.expert_v + (size_t)r * 512, (bf16*)(ws + WS_EV) + (size_t)r * 512, lane);
    }
    for (int m = gw; m < NTOK; m += NGW) rms_row_to_bf16(P.x + (size_t)m * DM, P.attn_norm_w, (bf16*)(ws + WS_XN) + (size_t)m * DM, lane);
    float* COS = (float*)(ws + WS_ROPE); float* SIN = COS + SEQ * 32;
    for (int e = gw * 64 + lane; e < SEQ * 32; e += NGW * 64) {
        const int pos = e >> 5, i = e & 31;
        const double inv = exp(-(double)i * (9.210340371976184 / 32.0));
        double s, c; sincos((double)pos * inv, &s, &c);
        COS[e] = (float)c; SIN[e] = (float)s;
    }
}
__device__ __forceinline__ void p5_hn(const Ptrs& P, int gw, int NGW, int lane) {
    for (int m = gw; m < NTOK; m += NGW) rms_row_to_bf16((const float*)(P.ws + WS_H) + (size_t)m * DM, P.ffn_norm_w, (bf16*)(P.ws + WS_HN) + (size_t)m * DM, lane);
}
__device__ __forceinline__ float lam_value(const Ptrs& P) {
    float a = 0.f, b = 0.f;
    for (int i = 0; i < DH; ++i) { a += P.lq1[i] * P.lk1[i]; b += P.lq2[i] * P.lk2[i]; }
    return expf(a) - expf(b) + LAMBDA_INIT;
}
__device__ __forceinline__ float sigmoidf_(float v) { return 1.f / (1.f + expf(-v)); }

__global__ void __launch_bounds__(512) nk_prep(Ptrs P) {
    extern __shared__ __attribute__((aligned(16))) unsigned char lds[];
    const int lane = threadIdx.x & 63, wave = threadIdx.x >> 6;
    p0_prologue(P, blockIdx.x * 8 + wave, gridDim.x * 8, lane, (LAS float*)lds + wave * (64 * 33));
}
__global__ void __launch_bounds__(256) nk_inproj(Ptrs P) {
    __shared__ float xr[4][DM];
    const int t0 = blockIdx.x * 4, tid = threadIdx.x;
    const bf16* XN = (const bf16*)(P.ws + WS_XN);
    for (int i = tid; i < 4 * DM; i += 256) xr[i >> 10][i & 1023] = bf2f(XN[(size_t)t0 * DM + i]);
    __syncthreads();
    const float* COS = (const float*)(P.ws + WS_ROPE); const float* SIN = COS + SEQ * 32;
    bf16* Q = (bf16*)(P.ws + WS_Q); unsigned char* KV = P.ws + WS_KV;
    bf16* SG = (bf16*)P.out;
    for (int j = tid; j < 4608; j += 256) {
        int c1, c2 = -1;
        if (j < 512) { c1 = (j >> 5) * 64 + (j & 31); c2 = c1 + 32; }
        else if (j < 1024) c1 = 1024 + (j - 512);
        else if (j < 2560) c1 = 1536 + (j - 1024);
        else c1 = 3072 + (j - 2560);
        float a0 = 0.f, a1 = 0.f, a2 = 0.f, a3 = 0.f, b0 = 0.f, b1 = 0.f, b2 = 0.f, b3 = 0.f;
        for (int k = 0; k < DM; ++k) {
            const float w1 = P.w_in[(size_t)k * INW + c1];
            a0 += xr[0][k] * w1; a1 += xr[1][k] * w1; a2 += xr[2][k] * w1; a3 += xr[3][k] * w1;
            if (c2 >= 0) { const float w2 = P.w_in[(size_t)k * INW + c2]; b0 += xr[0][k] * w2; b1 += xr[1][k] * w2; b2 += xr[2][k] * w2; b3 += xr[3][k] * w2; }
        }
#pragma unroll
        for (int r = 0; r < 4; ++r) {
            const float a = r == 0 ? a0 : r == 1 ? a1 : r == 2 ? a2 : a3, b = r == 0 ? b0 : r == 1 ? b1 : r == 2 ? b2 : b3;
            const int t = t0 + r, bb = t >> 12, pos = t & 4095, tile = pos >> 6, kvr = pos & 63;
            if (j < 512) {
                const int g = j >> 5, i = j & 31; const float cs = COS[pos * 32 + i], sn = SIN[pos * 32 + i];
                const float o1 = a * cs - b * sn, o2 = b * cs + a * sn;
                if (g < 8) { Q[(size_t)t * QKW + g * 64 + 2 * i] = (bf16)f2bf(o1 * C2); Q[(size_t)t * QKW + g * 64 + 2 * i + 1] = (bf16)f2bf(o2 * C2); }
                else { const int gk = g - 8, h = gk >> 1, m = gk & 1; unsigned char* tb = KV + kv_tile_off(bb, h, tile);
                    *(bf16*)(tb + k_img_off(m, kvr, 2 * i)) = (bf16)f2bf(o1); *(bf16*)(tb + k_img_off(m, kvr, 2 * i + 1)) = (bf16)f2bf(o2); }
            } else if (j < 1024) { const int ee = j - 512, h = ee >> 7, e = ee & 127; *(bf16*)(KV + kv_tile_off(bb, h, tile) + v_img_off(kvr, e)) = (bf16)f2bf(a); }
            else if (j < 2560) { const int jj = j - 1024, which = jj >> 9, cc = jj & 511; bf16* dst = (bf16*)(P.ws + (which == 0 ? WS_BG : which == 1 ? WS_CG : WS_XC)); dst[(size_t)t * CW + cc] = (bf16)f2bf(a); }
            else { const int jj = j - 2560, which = jj >> 10, cc = jj & 1023; SG[(size_t)which * NTOK * DM + (size_t)t * DM + cc] = (bf16)f2bf(sigmoidf_(a)); }
        }
    }
}
__device__ __forceinline__ void conv_rows(const Ptrs& P, int gw, int NGW, int lane) {
    const bf16* BG = (const bf16*)(P.ws + WS_BG); const bf16* CG = (const bf16*)(P.ws + WS_CG); const bf16* XC = (const bf16*)(P.ws + WS_XC); bf16* CF = (bf16*)(P.ws + WS_CF);
    for (int t = gw; t < NTOK; t += NGW) {
        const int pos = t & 4095; const size_t o = (size_t)t * CW + lane * 8;
        const u32x4 g = *(const u32x4*)(BG + o), c1 = *(const u32x4*)(CG + o), x1 = *(const u32x4*)(XC + o);
        u32x4 c0 = (u32x4){0, 0, 0, 0}, x0 = c0, c2 = c0, x2 = c0;
        if (pos > 0) { c0 = *(const u32x4*)(CG + o - CW); x0 = *(const u32x4*)(XC + o - CW); }
        if (pos < SEQ - 1) { c2 = *(const u32x4*)(CG + o + CW); x2 = *(const u32x4*)(XC + o + CW); }
        const f32x4 wa0 = *(const f32x4*)(P.conv_w + lane * 8), wa1 = *(const f32x4*)(P.conv_w + lane * 8 + 4);
        const f32x4 wb0 = *(const f32x4*)(P.conv_w + CW + lane * 8), wb1 = *(const f32x4*)(P.conv_w + CW + lane * 8 + 4);
        const f32x4 wc0 = *(const f32x4*)(P.conv_w + 2 * CW + lane * 8), wc1 = *(const f32x4*)(P.conv_w + 2 * CW + lane * 8 + 4);
        float r[8];
#pragma unroll
        for (int q = 0; q < 4; ++q) {
            const float w0l = q < 2 ? wa0[2 * q] : wa1[2 * q - 4], w0h = q < 2 ? wa0[2 * q + 1] : wa1[2 * q - 3];
            const float w1l = q < 2 ? wb0[2 * q] : wb1[2 * q - 4], w1h = q < 2 ? wb0[2 * q + 1] : wb1[2 * q - 3];
            const float w2l = q < 2 ? wc0[2 * q] : wc1[2 * q - 4], w2h = q < 2 ? wc0[2 * q + 1] : wc1[2 * q - 3];
            r[2 * q] = bflo(g[q]) * (w0l * bflo(c0[q]) * bflo(x0[q]) + w1l * bflo(c1[q]) * bflo(x1[q]) + w2l * bflo(c2[q]) * bflo(x2[q]));
            r[2 * q + 1] = bfhi(g[q]) * (w0h * bfhi(c0[q]) * bfhi(x0[q]) + w1h * bfhi(c1[q]) * bfhi(x1[q]) + w2h * bfhi(c2[q]) * bfhi(x2[q]));
        }
        u32x4 ov; ov.x = pk2(r[0], r[1]); ov.y = pk2(r[2], r[3]); ov.z = pk2(r[4], r[5]); ov.w = pk2(r[6], r[7]);
        *(u32x4*)(CF + o) = ov;
    }
}
__global__ void __launch_bounds__(512) nk_conv(Ptrs P) { conv_rows(P, blockIdx.x * 8 + (threadIdx.x >> 6), gridDim.x * 8, threadIdx.x & 63); }
__global__ void __launch_bounds__(256) nk_attn(Ptrs P) {
    const int gid = blockIdx.x * 256 + threadIdx.x;
    const int q = gid & 4095, eq = (gid >> 12) & 3, m = (gid >> 14) & 1, h = (gid >> 15) & 3, b = gid >> 17;
    const bf16* Q = (const bf16*)(P.ws + WS_Q); const unsigned char* KV = P.ws + WS_KV;
    const int t = b * SEQ + q;
    float qv[64];
#pragma unroll
    for (int p = 0; p < 64; ++p) qv[p] = bf2f(Q[(size_t)t * QKW + (h * 2 + m) * 64 + p]);
    float o[32];
#pragma unroll
    for (int e = 0; e < 32; ++e) o[e] = 0.f;
    float mx = -1e30f, l = 0.f;
    for (int kv = 0; kv < SEQ; ++kv) {
        const unsigned char* tb = KV + kv_tile_off(b, h, kv >> 6); const int kvr = kv & 63;
        float s = 0.f;
#pragma unroll
        for (int c = 0; c < 8; ++c) { const u32x4 kk = *(const u32x4*)(tb + k_img_off(m, kvr, c * 8));
#pragma unroll
            for (int w = 0; w < 4; ++w) s += qv[c * 8 + 2 * w] * bflo(kk[w]) + qv[c * 8 + 2 * w + 1] * bfhi(kk[w]); }
        if (s > mx) { const float f = exp2f(mx - s); l *= f;
#pragma unroll
            for (int e = 0; e < 32; ++e) o[e] *= f;
            mx = s; }
        const float p = exp2f(s - mx); l += p;
#pragma unroll
        for (int c = 0; c < 4; ++c) { const u32x4 vv = *(const u32x4*)(tb + v_img_off(kvr, eq * 32 + c * 8));
#pragma unroll
            for (int w = 0; w < 4; ++w) { o[c * 8 + 2 * w] += p * bflo(vv[w]); o[c * 8 + 2 * w + 1] += p * bfhi(vv[w]); } }
    }
    float* TMPF = (float*)(P.ws + WS_H);
    const float rl = 1.f / l;
#pragma unroll
    for (int e = 0; e < 32; ++e) TMPF[((size_t)((b * NH + h) * SEQ + q) * 2 + m) * DV + eq * 32 + e] = o[e] * rl;
}
__global__ void __launch_bounds__(256) nk_attn_fin(Ptrs P) {
    const int gw = blockIdx.x * 4 + (threadIdx.x >> 6), lane = threadIdx.x & 63;
    const int q = gw & 4095, h = (gw >> 12) & 3, b = gw >> 14;
    const float lam = lam_value(P);
    const float* TMPF = (const float*)(P.ws + WS_H) + (size_t)gw * 2 * DV;
    const float d0 = TMPF[lane * 2] - lam * TMPF[DV + lane * 2], d1 = TMPF[lane * 2 + 1] - lam * TMPF[DV + lane * 2 + 1];
    const float rstd = rsqrtf(wave_sum(d0 * d0 + d1 * d1) * (1.f / DV) + EPS) * (1.f - LAMBDA_INIT);
    bf16* AT = (bf16*)(P.ws + WS_ATTN);
    *(unsigned*)(AT + (size_t)(b * SEQ + q) * AW + h * DV + lane * 2) = pk2(d0 * rstd * P.subln_w[lane * 2], d1 * rstd * P.subln_w[lane * 2 + 1]);
}
__global__ void __launch_bounds__(256) nk_merge(Ptrs P) {
    __shared__ float ar[4][AW]; __shared__ float cr[4][CW];
    const int t0 = blockIdx.x * 4, tid = threadIdx.x;
    const bf16* AT = (const bf16*)(P.ws + WS_ATTN); const bf16* CF = (const bf16*)(P.ws + WS_CF);
    for (int i = tid; i < 4 * AW; i += 256) { ar[i >> 9][i & 511] = bf2f(AT[(size_t)t0 * AW + i]); cr[i >> 9][i & 511] = bf2f(CF[(size_t)t0 * CW + i]); }
    __syncthreads();
    const bf16* SG = (const bf16*)P.out; bf16* MG = (bf16*)(P.ws + WS_MG);
    for (int n = tid; n < DM; n += 256) {
        float a[4] = {0.f, 0.f, 0.f, 0.f}, c[4] = {0.f, 0.f, 0.f, 0.f};
        for (int k = 0; k < AW; ++k) { const float wa = P.w_pa[(size_t)k * DM + n], wb = P.w_pb[(size_t)k * DM + n];
#pragma unroll
            for (int r = 0; r < 4; ++r) { a[r] += ar[r][k] * wa; c[r] += cr[r][k] * wb; } }
#pragma unroll
        for (int r = 0; r < 4; ++r) { const size_t o = (size_t)(t0 + r) * DM + n;
            MG[o] = (bf16)f2bf(bf2f(SG[o]) * a[r] + bf2f(SG[(size_t)NTOK * DM + o]) * c[r]); }
    }
}
__global__ void __launch_bounds__(256) nk_wo(Ptrs P) {
    __shared__ float ar[4][DM];
    const int t0 = blockIdx.x * 4, tid = threadIdx.x;
    const bf16* MG = (const bf16*)(P.ws + WS_MG);
    for (int i = tid; i < 4 * DM; i += 256) ar[i >> 10][i & 1023] = bf2f(MG[(size_t)t0 * DM + i]);
    __syncthreads();
    float* H = (float*)(P.ws + WS_H);
    for (int n = tid; n < DM; n += 256) {
        float a[4] = {0.f, 0.f, 0.f, 0.f};
        for (int k = 0; k < DM; ++k) { const float w = P.w_o[(size_t)k * DM + n];
#pragma unroll
            for (int r = 0; r < 4; ++r) a[r] += ar[r][k] * w; }
#pragma unroll
        for (int r = 0; r < 4; ++r) { const size_t o = (size_t)(t0 + r) * DM + n; H[o] = P.x[o] + a[r]; }
    }
}
__global__ void __launch_bounds__(512) nk_hn(Ptrs P) { p5_hn(P, blockIdx.x * 8 + (threadIdx.x >> 6), gridDim.x * 8, threadIdx.x & 63); }
__global__ void __launch_bounds__(256) nk_wq(Ptrs P) {
    __shared__ float ar[4][DM];
    const int t0 = blockIdx.x * 4, tid = threadIdx.x;
    const bf16* HN = (const bf16*)(P.ws + WS_HN);
    for (int i = tid; i < 4 * DM; i += 256) ar[i >> 10][i & 1023] = bf2f(HN[(size_t)t0 * DM + i]);
    __syncthreads();
    bf16* QP = (bf16*)(P.ws + WS_QP);
    for (int n = tid; n < QPW; n += 256) {
        float a[4] = {0.f, 0.f, 0.f, 0.f};
        for (int k = 0; k < DM; ++k) { const float w = P.w_query[(size_t)k * QPW + n];
#pragma unroll
            for (int r = 0; r < 4; ++r) a[r] += ar[r][k] * w; }
#pragma unroll
        for (int r = 0; r < 4; ++r) QP[(size_t)(t0 + r) * QPW + n] = (bf16)f2bf(a[r]);
    }
}
__device__ __forceinline__ unsigned f2h(float f) { _Float16 h = (_Float16)f; return (unsigned)__builtin_bit_cast(unsigned short, h); }
__device__ __forceinline__ float h2f(unsigned u) { return (float)__builtin_bit_cast(_Float16, (unsigned short)(u & 0xffffu)); }
__global__ void __launch_bounds__(64) nk_topk(Ptrs P) {
    extern __shared__ __attribute__((aligned(16))) unsigned char ldsraw[];
    float* sc = (float*)ldsraw + threadIdx.x * 256;
    float* tv = (float*)ldsraw + 64 * 256 + threadIdx.x * 32;
    int* ti = (int*)((float*)ldsraw + 64 * 256 + 64 * 32) + threadIdx.x * 32;
    const int gid = blockIdx.x * 64 + threadIdx.x, t = gid >> 3, hd = gid & 7;
    const bf16* QP = (const bf16*)(P.ws + WS_QP) + (size_t)t * QPW + hd * 256;
    for (int p = 0; p < 2; ++p)
        for (int n = 0; n < NKEY; ++n) { const float* key = P.sub_keys + ((size_t)(hd * 2 + p) * NKEY + n) * PHD; float s = 0.f;
            for (int d = 0; d < PHD; ++d) s += bf2f(QP[p * 128 + d]) * key[d];
            sc[p * 128 + n] = s; }
    for (int p = 0; p < 2; ++p)
        for (int r = 0; r < TOPK; ++r) { float best = -3e38f; int bi = 0;
            for (int n = 0; n < NKEY; ++n) { const float v = sc[p * 128 + n]; if (v > best) { best = v; bi = n; } }
            tv[p * 16 + r] = best; ti[p * 16 + r] = bi; sc[p * 128 + bi] = -3e38f; }
    for (int i = 0; i < 16; ++i) for (int j = 0; j < 16; ++j) sc[i * 16 + j] = tv[i] + tv[16 + j];
    float top[16]; int eid[16];
#pragma unroll
    for (int r = 0; r < TOPK; ++r) { float best = -3e38f; int bi = 0;
        for (int n = 0; n < 256; ++n) { const float v = sc[n]; if (v > best) { best = v; bi = n; } }
        top[r] = best; eid[r] = ti[bi >> 4] * NKEY + ti[16 + (bi & 15)]; sc[bi] = -3e38f; }
    float sum = 0.f; const float tmax = top[0];
#pragma unroll
    for (int r = 0; r < TOPK; ++r) { top[r] = expf(top[r] - tmax); sum += top[r]; }
    unsigned* SEL = (unsigned*)(P.ws + WS_SEL) + (size_t)t * 128 + hd * 16;
#pragma unroll
    for (int r = 0; r < TOPK; ++r) SEL[r] = ((unsigned)eid[r] << 16) | f2h(top[r] / sum);
}
__global__ void __launch_bounds__(256) nk_peer(Ptrs P) {
    __shared__ float hn[DM]; __shared__ float wk[128]; __shared__ int ek[128]; __shared__ float red[4];
    const int t = blockIdx.x, tid = threadIdx.x;
    const bf16* HN = (const bf16*)(P.ws + WS_HN) + (size_t)t * DM;
    for (int i = tid; i < DM; i += 256) hn[i] = bf2f(HN[i]);
    __syncthreads();
    if (tid < 128) { const unsigned s = ((const unsigned*)(P.ws + WS_SEL))[(size_t)t * 128 + tid]; const int e = s >> 16; const float g = h2f(s);
        const float* u = P.expert_u + (size_t)e * DM; float a = 0.f;
        for (int d = 0; d < DM; ++d) a += u[d] * hn[d];
        const float ge = 0.5f * a * (1.f + erff(a * 0.70710678118654752f));
        wk[tid] = g * ge; ek[tid] = e; }
    __syncthreads();
    const float* H = (const float*)(P.ws + WS_H) + (size_t)t * DM;
    float y[4]; float ss = 0.f;
#pragma unroll
    for (int r = 0; r < 4; ++r) { const int d = tid + 256 * r; float o = 0.f;
        for (int k = 0; k < 128; ++k) o += wk[k] * P.expert_v[(size_t)ek[k] * DM + d];
        y[r] = H[d] + o; ss += y[r] * y[r]; }
    ss = wave_sum(ss);
    if ((tid & 63) == 0) red[tid >> 6] = ss;
    __syncthreads();
    const float rstd = rsqrtf((red[0] + red[1] + red[2] + red[3]) * (1.f / DM) + EPS);
#pragma unroll
    for (int r = 0; r < 4; ++r) { const int d = tid + 256 * r; P.out[(size_t)t * DM + d] = y[r] * rstd * P.final_norm_w[d]; }
}
extern "C" void kernel_launch(void* const* d_in, const int* in_sizes, int n_in, void* d_out, int out_size, void* d_ws, size_t ws_size, hipStream_t stream) {
    Ptrs P{};
    const float** pp = (const float**)&P;
    for (int i = 0; i < 18; ++i) pp[i] = (const float*)d_in[i];
    P.out = (float*)d_out; P.ws = (unsigned char*)d_ws;
    static bool once = false;
    if (!once) { hipFuncSetAttribute((const void*)nk_prep, hipFuncAttributeMaxDynamicSharedMemorySize, 8 * 64 * 33 * 4); hipFuncSetAttribute((const void*)nk_topk, hipFuncAttributeMaxDynamicSharedMemorySize, 64 * 320 * 4); once = true; }
    hipLaunchKernelGGL(nk_prep, dim3(256), dim3(512), 8 * 64 * 33 * 4, stream, P);
    hipLaunchKernelGGL(nk_inproj, dim3(NTOK / 4), dim3(256), 0, stream, P);
    hipLaunchKernelGGL(nk_conv, dim3(256), dim3(512), 0, stream, P);
    hipLaunchKernelGGL(nk_attn, dim3(NB * NH * 2 * 4 * SEQ / 256), dim3(256), 0, stream, P);
    hipLaunchKernelGGL(nk_attn_fin, dim3(NB * NH * SEQ / 4), dim3(256), 0, stream, P);
    hipLaunchKernelGGL(nk_merge, dim3(NTOK / 4), dim3(256), 0, stream, P);
    hipLaunchKernelGGL(nk_wo, dim3(NTOK / 4), dim3(256), 0, stream, P);
    hipLaunchKernelGGL(nk_hn, dim3(256), dim3(512), 0, stream, P);
    hipLaunchKernelGGL(nk_wq, dim3(NTOK / 4), dim3(256), 0, stream, P);
    hipLaunchKernelGGL(nk_topk, dim3(NTOK * PH / 64), dim3(64), 64 * 320 * 4, stream, P);
    hipLaunchKernelGGL(nk_peer, dim3(NTOK), dim3(256), 0, stream, P);
}
```

```cpp
#include <hip/hip_runtime.h>
#include <cstdint>
#include <cstdio>

constexpr int NB = 4, SEQ = 4096, DM = 1024, NTOK = NB * SEQ;
constexpr int NH = 4, DH = 64, DV = 128, QKW = 512, AW = 512, CW = 512;
constexpr int INW = 5120;
constexpr int PH = 8, NKEY = 128, PHD = 128, TOPK = 16, NEXP = 16384, QPW = 2048;
constexpr float EPS = 1e-6f;
constexpr float LAMBDA_INIT = 0.2f;
constexpr float C2 = 0.125f * 1.4426950408889634f;

constexpr size_t MiB = 1u << 20;
constexpr size_t WS_CTL = 0, CTL_BYTES = 1 * MiB;
constexpr size_t WS_WIN = 1 * MiB;
constexpr size_t WS_WPA = 11 * MiB;
constexpr size_t WS_WPB = 12 * MiB;
constexpr size_t WS_WO = 13 * MiB;
constexpr size_t WS_WQ = 15 * MiB;
constexpr size_t WS_KEYS = 19 * MiB;
constexpr size_t WS_ROPE = 20 * MiB;
constexpr size_t WS_EU = 21 * MiB;
constexpr size_t WS_EV = 53 * MiB;
constexpr size_t WS_XN = 85 * MiB;
constexpr size_t WS_ATTN = 85 * MiB;
constexpr size_t WS_CF = 101 * MiB;
constexpr size_t WS_HN = 85 * MiB;
constexpr size_t WS_Q = 117 * MiB;
constexpr size_t WS_KV = 133 * MiB;
constexpr size_t WS_BG = 165 * MiB, WS_CG = 181 * MiB, WS_XC = 197 * MiB;
constexpr size_t WS_MG = 117 * MiB;
constexpr size_t WS_TMP = 149 * MiB;
constexpr size_t WS_H = 181 * MiB;
constexpr size_t WS_QP = 117 * MiB;
constexpr size_t WS_SEL = 245 * MiB;
constexpr size_t WS_END = 256 * MiB;

typedef unsigned short bf16;
typedef float f32x4 __attribute__((ext_vector_type(4)));
typedef float f32x16 __attribute__((ext_vector_type(16)));
typedef float f32x2 __attribute__((ext_vector_type(2)));
typedef unsigned u32x4 __attribute__((ext_vector_type(4)));
typedef unsigned u32x2 __attribute__((ext_vector_type(2)));
typedef short bf16x8 __attribute__((ext_vector_type(8)));
#define LAS __attribute__((address_space(3)))

__host__ __device__ __forceinline__ unsigned f2bf(float f) { unsigned u = __builtin_bit_cast(unsigned, f); return (u + 0x7fffu + ((u >> 16) & 1u)) >> 16; }
__host__ __device__ __forceinline__ unsigned pk2(float lo, float hi) { return f2bf(lo) | (f2bf(hi) << 16); }
__host__ __device__ __forceinline__ float bf2f(unsigned h) { return __builtin_bit_cast(float, (h & 0xffffu) << 16); }
__device__ __forceinline__ float bflo(unsigned w) { return __builtin_bit_cast(float, w << 16); }
__device__ __forceinline__ float bfhi(unsigned w) { return __builtin_bit_cast(float, w & 0xffff0000u); }

__host__ __device__ __forceinline__ size_t kv_tile_off(int b, int h, int tile) { return (size_t)((b * NH + h) * 64 + tile) * 32768; }
__host__ __device__ __forceinline__ int k_img_off(int m, int kvr, int p) { return m * 8192 + (p >> 3) * 1024 + kvr * 16 + (p & 7) * 2; }
__host__ __device__ __forceinline__ int v_img_off(int kvr, int e) { return 16384 + (e >> 5) * 4096 + (kvr >> 4) * 1024 + (kvr & 15) * 64 + (e & 31) * 2; }
struct Ptrs {
    const float *x, *attn_norm_w, *w_in, *lq1, *lk1, *lq2, *lk2, *subln_w, *conv_w, *w_pa, *w_pb, *w_o, *ffn_norm_w, *w_query, *sub_keys, *expert_u, *expert_v, *final_norm_w;
    float* out; unsigned char* ws;
};
__device__ __forceinline__ float wave_sum(float v) {
#pragma unroll
    for (int o = 1; o < 64; o <<= 1) v += __shfl_xor(v, o);
    return v;
}
__device__ __forceinline__ int rope_row(int c) { if (c < 1024) { const int g = c >> 6, d = c & 63; return (g << 6) + 2 * (d & 31) + (d >> 5); } return c; }
template <int MAP>
__device__ __forceinline__ void p0_transpose_item(const float* W, int K, int N, bf16* WT, LAS float* scr, int item, int lane) {
    const int nblk = N / 32, kb = item / nblk, nb = item % nblk, k0 = 64 * kb, n0 = 32 * nb;
#pragma unroll 8
    for (int i = 0; i < 32; ++i) { const int kk = 2 * i + (lane >> 5); scr[kk * 33 + (lane & 31)] = W[(size_t)(k0 + kk) * N + n0 + (lane & 31)]; }
    asm volatile("s_waitcnt lgkmcnt(0)" ::: "memory");
    const int c = lane & 7;
#pragma unroll
    for (int j = 0; j < 4; ++j) { const int n = (lane >> 3) + 8 * j; const LAS float* s = scr + (8 * c) * 33 + n;
        u32x4 o; o.x = pk2(s[0 * 33], s[1 * 33]); o.y = pk2(s[2 * 33], s[3 * 33]); o.z = pk2(s[4 * 33], s[5 * 33]); o.w = pk2(s[6 * 33], s[7 * 33]);
        const int drow = MAP ? rope_row(n0 + n) : (n0 + n);
        *(u32x4*)(WT + (size_t)drow * K + k0 + 8 * c) = o; }
    asm volatile("s_waitcnt lgkmcnt(0)" ::: "memory");
}
__device__ __forceinline__ void p0_cvt_chunk(const float* src, bf16* dst, int lane) {
    const f32x4 a = *(const f32x4*)(src + lane * 8), b = *(const f32x4*)(src + lane * 8 + 4);
    u32x4 o; o.x = pk2(a.x, a.y); o.y = pk2(a.z, a.w); o.z = pk2(b.x, b.y); o.w = pk2(b.z, b.w);
    *(u32x4*)(dst + lane * 8) = o;
}
__device__ __forceinline__ void rms_row_to_bf16(const float* xrow, const float* w, bf16* orow, int lane) {
    const f32x4* xr = (const f32x4*)xrow + lane; const f32x4* wr = (const f32x4*)w + lane;
    f32x4 v[4]; float s = 0.f;
#pragma unroll
    for (int j = 0; j < 4; ++j) { v[j] = xr[64 * j]; s += (v[j].x * v[j].x + v[j].y * v[j].y) + (v[j].z * v[j].z + v[j].w * v[j].w); }
    const float rstd = rsqrtf(wave_sum(s) * (1.f / DM) + EPS);
    unsigned long long* o8 = (unsigned long long*)orow + lane;
#pragma unroll
    for (int j = 0; j < 4; ++j) { const f32x4 ww = wr[64 * j];
        o8[64 * j] = (unsigned long long)pk2(v[j].x * rstd * ww.x, v[j].y * rstd * ww.y) | ((unsigned long long)pk2(v[j].z * rstd * ww.z, v[j].w * rstd * ww.w) << 32); }
}
__device__ __forceinline__ void p0_prologue(const Ptrs& P, int gw, int NGW, int lane, LAS float* scr) {
    unsigned char* ws = P.ws;
    bf16* WIN = (bf16*)(ws + WS_WIN); bf16* WPA = (bf16*)(ws + WS_WPA); bf16* WPB = (bf16*)(ws + WS_WPB); bf16* WO = (bf16*)(ws + WS_WO); bf16* WQ = (bf16*)(ws + WS_WQ);
    constexpr int I_IN = (DM / 64) * (INW / 32), I_PA = (AW / 64) * (DM / 32), I_PB = (CW / 64) * (DM / 32), I_O = (DM / 64) * (DM / 32), I_Q = (DM / 64) * (QPW / 32);
    constexpr int NITEMS = I_IN + I_PA + I_PB + I_O + I_Q;
    for (int it = gw; it < NITEMS; it += NGW) {
        int r = it;
        if (r < I_IN) { p0_transpose_item<1>(P.w_in, DM, INW, WIN, scr, r, lane); continue; } r -= I_IN;
        if (r < I_PA) { p0_transpose_item<0>(P.w_pa, AW, DM, WPA, scr, r, lane); continue; } r -= I_PA;
        if (r < I_PB) { p0_transpose_item<0>(P.w_pb, CW, DM, WPB, scr, r, lane); continue; } r -= I_PB;
        if (r < I_O) { p0_transpose_item<0>(P.w_o, DM, DM, WO, scr, r, lane); continue; } r -= I_O;
        p0_transpose_item<0>(P.w_query, DM, QPW, WQ, scr, r, lane);
    }
    constexpr int C_K = (PH * 2 * NKEY * PHD) / 512, C_E = (NEXP * DM) / 512;
    for (int it = gw; it < C_K + 2 * C_E; it += NGW) {
        int r = it;
        if (r < C_K) { p0_cvt_chunk(P.sub_keys + (size_t)r * 512, (bf16*)(ws + WS_KEYS) + (size_t)r * 512, lane); continue; } r -= C_K;
        if (r < C_E) { p0_cvt_chunk(P.expert_u + (size_t)r * 512, (bf16*)(ws + WS_EU) + (size_t)r * 512, lane); continue; } r -= C_E;
        p0_cvt_chunk(P.expert_v + (size_t)r * 512, (bf16*)(ws + WS_EV) + (size_t)r * 512, lane);
    }
    for (int m = gw; m < NTOK; m += NGW) rms_row_to_bf16(P.x + (size_t)m * DM, P.attn_norm_w, (bf16*)(ws + WS_XN) + (size_t)m * DM, lane);
    float* COS = (float*)(ws + WS_ROPE); float* SIN = COS + SEQ * 32;
    for (int e = gw * 64 + lane; e < SEQ * 32; e += NGW * 64) {
        const int pos = e >> 5, i = e & 31;
        const double inv = exp(-(double)i * (9.210340371976184 / 32.0));
        double s, c; sincos((double)pos * inv, &s, &c);
        COS[e] = (float)c; SIN[e] = (float)s;
    }
}
__device__ __forceinline__ void p5_hn(const Ptrs& P, int gw, int NGW, int lane) {
    for (int m = gw; m < NTOK; m += NGW) rms_row_to_bf16((const float*)(P.ws + WS_H) + (size_t)m * DM, P.ffn_norm_w, (bf16*)(P.ws + WS_HN) + (size_t)m * DM, lane);
}
__device__ __forceinline__ float lam_value(const Ptrs& P) {
    float a = 0.f, b = 0.f;
    for (int i = 0; i < DH; ++i) { a += P.lq1[i] * P.lk1[i]; b += P.lq2[i] * P.lk2[i]; }
    return expf(a) - expf(b) + LAMBDA_INIT;
}
__device__ __forceinline__ float sigmoidf_(float v) { return 1.f / (1.f + expf(-v)); }

__global__ void __launch_bounds__(512) nk_prep(Ptrs P) {
    extern __shared__ __attribute__((aligned(16))) unsigned char lds[];
    const int lane = threadIdx.x & 63, wave = threadIdx.x >> 6;
    p0_prologue(P, blockIdx.x * 8 + wave, gridDim.x * 8, lane, (LAS float*)lds + wave * (64 * 33));
}
__global__ void __launch_bounds__(256) nk_inproj(Ptrs P) {
    __shared__ float xr[4][DM];
    const int t0 = blockIdx.x * 4, tid = threadIdx.x;
    const bf16* XN = (const bf16*)(P.ws + WS_XN);
    for (int i = tid; i < 4 * DM; i += 256) xr[i >> 10][i & 1023] = bf2f(XN[(size_t)t0 * DM + i]);
    __syncthreads();
    const float* COS = (const float*)(P.ws + WS_ROPE); const float* SIN = COS + SEQ * 32;
    bf16* Q = (bf16*)(P.ws + WS_Q); unsigned char* KV = P.ws + WS_KV;
    bf16* SG = (bf16*)P.out;
    for (int j = tid; j < 4608; j += 256) {
        int c1, c2 = -1;
        if (j < 512) { c1 = (j >> 5) * 64 + (j & 31); c2 = c1 + 32; }
        else if (j < 1024) c1 = 1024 + (j - 512);
        else if (j < 2560) c1 = 1536 + (j - 1024);
        else c1 = 3072 + (j - 2560);
        float a0 = 0.f, a1 = 0.f, a2 = 0.f, a3 = 0.f, b0 = 0.f, b1 = 0.f, b2 = 0.f, b3 = 0.f;
        for (int k = 0; k < DM; ++k) {
            const float w1 = P.w_in[(size_t)k * INW + c1];
            a0 += xr[0][k] * w1; a1 += xr[1][k] * w1; a2 += xr[2][k] * w1; a3 += xr[3][k] * w1;
            if (c2 >= 0) { const float w2 = P.w_in[(size_t)k * INW + c2]; b0 += xr[0][k] * w2; b1 += xr[1][k] * w2; b2 += xr[2][k] * w2; b3 += xr[3][k] * w2; }
        }
#pragma unroll
        for (int r = 0; r < 4; ++r) {
            const float a = r == 0 ? a0 : r == 1 ? a1 : r == 2 ? a2 : a3, b = r == 0 ? b0 : r == 1 ? b1 : r == 2 ? b2 : b3;
            const int t = t0 + r, bb = t >> 12, pos = t & 4095, tile = pos >> 6, kvr = pos & 63;
            if (j < 512) {
                const int g = j >> 5, i = j & 31; const float cs = COS[pos * 32 + i], sn = SIN[pos * 32 + i];
                const float o1 = a * cs - b * sn, o2 = b * cs + a * sn;
                if (g < 8) { Q[(size_t)t * QKW + g * 64 + 2 * i] = (bf16)f2bf(o1 * C2); Q[(size_t)t * QKW + g * 64 + 2 * i + 1] = (bf16)f2bf(o2 * C2); }
                else { const int gk = g - 8, h = gk >> 1, m = gk & 1; unsigned char* tb = KV + kv_tile_off(bb, h, tile);
                    *(bf16*)(tb + k_img_off(m, kvr, 2 * i)) = (bf16)f2bf(o1); *(bf16*)(tb + k_img_off(m, kvr, 2 * i + 1)) = (bf16)f2bf(o2); }
            } else if (j < 1024) { const int ee = j - 512, h = ee >> 7, e = ee & 127; *(bf16*)(KV + kv_tile_off(bb, h, tile) + v_img_off(kvr, e)) = (bf16)f2bf(a); }
            else if (j < 2560) { const int jj = j - 1024, which = jj >> 9, cc = jj & 511; bf16* dst = (bf16*)(P.ws + (which == 0 ? WS_BG : which == 1 ? WS_CG : WS_XC)); dst[(size_t)t * CW + cc] = (bf16)f2bf(a); }
            else { const int jj = j - 2560, which = jj >> 10, cc = jj & 1023; SG[(size_t)which * NTOK * DM + (size_t)t * DM + cc] = (bf16)f2bf(sigmoidf_(a)); }
        }
    }
}
__device__ __forceinline__ void conv_rows(const Ptrs& P, int gw, int NGW, int lane) {
    const bf16* BG = (const bf16*)(P.ws + WS_BG); const bf16* CG = (const bf16*)(P.ws + WS_CG); const bf16* XC = (const bf16*)(P.ws + WS_XC); bf16* CF = (bf16*)(P.ws + WS_CF);
    for (int t = gw; t < NTOK; t += NGW) {
        const int pos = t & 4095; const size_t o = (size_t)t * CW + lane * 8;
        const u32x4 g = *(const u32x4*)(BG + o), c1 = *(const u32x4*)(CG + o), x1 = *(const u32x4*)(XC + o);
        u32x4 c0 = (u32x4){0, 0, 0, 0}, x0 = c0, c2 = c0, x2 = c0;
        if (pos > 0) { c0 = *(const u32x4*)(CG + o - CW); x0 = *(const u32x4*)(XC + o - CW); }
        if (pos < SEQ - 1) { c2 = *(const u32x4*)(CG + o + CW); x2 = *(const u32x4*)(XC + o + CW); }
        const f32x4 wa0 = *(const f32x4*)(P.conv_w + lane * 8), wa1 = *(const f32x4*)(P.conv_w + lane * 8 + 4);
        const f32x4 wb0 = *(const f32x4*)(P.conv_w + CW + lane * 8), wb1 = *(const f32x4*)(P.conv_w + CW + lane * 8 + 4);
        const f32x4 wc0 = *(const f32x4*)(P.conv_w + 2 * CW + lane * 8), wc1 = *(const f32x4*)(P.conv_w + 2 * CW + lane * 8 + 4);
        float r[8];
#pragma unroll
        for (int q = 0; q < 4; ++q) {
            const float w0l = q < 2 ? wa0[2 * q] : wa1[2 * q - 4], w0h = q < 2 ? wa0[2 * q + 1] : wa1[2 * q - 3];
            const float w1l = q < 2 ? wb0[2 * q] : wb1[2 * q - 4], w1h = q < 2 ? wb0[2 * q + 1] : wb1[2 * q - 3];
            const float w2l = q < 2 ? wc0[2 * q] : wc1[2 * q - 4], w2h = q < 2 ? wc0[2 * q + 1] : wc1[2 * q - 3];
            r[2 * q] = bflo(g[q]) * (w0l * bflo(c0[q]) * bflo(x0[q]) + w1l * bflo(c1[q]) * bflo(x1[q]) + w2l * bflo(c2[q]) * bflo(x2[q]));
            r[2 * q + 1] = bfhi(g[q]) * (w0h * bfhi(c0[q]) * bfhi(x0[q]) + w1h * bfhi(c1[q]) * bfhi(x1[q]) + w2h * bfhi(c2[q]) * bfhi(x2[q]));
        }
        u32x4 ov; ov.x = pk2(r[0], r[1]); ov.y = pk2(r[2], r[3]); ov.z = pk2(r[4], r[5]); ov.w = pk2(r[6], r[7]);
        *(u32x4*)(CF + o) = ov;
    }
}
__global__ void __launch_bounds__(512) nk_conv(Ptrs P) { conv_rows(P, blockIdx.x * 8 + (threadIdx.x >> 6), gridDim.x * 8, threadIdx.x & 63); }
__global__ void __launch_bounds__(256) nk_attn(Ptrs P) {
    const int gid = blockIdx.x * 256 + threadIdx.x;
    const int q = gid & 4095, eq = (gid >> 12) & 3, m = (gid >> 14) & 1, h = (gid >> 15) & 3, b = gid >> 17;
    const bf16* Q = (const bf16*)(P.ws + WS_Q); const unsigned char* KV = P.ws + WS_KV;
    const int t = b * SEQ + q;
    float qv[64];
#pragma unroll
    for (int p = 0; p < 64; ++p) qv[p] = bf2f(Q[(size_t)t * QKW + (h * 2 + m) * 64 + p]);
    float o[32];
#pragma unroll
    for (int e = 0; e < 32; ++e) o[e] = 0.f;
    float mx = -1e30f, l = 0.f;
    for (int kv = 0; kv < SEQ; ++kv) {
        const unsigned char* tb = KV + kv_tile_off(b, h, kv >> 6); const int kvr = kv & 63;
        float s = 0.f;
#pragma unroll
        for (int c = 0; c < 8; ++c) { const u32x4 kk = *(const u32x4*)(tb + k_img_off(m, kvr, c * 8));
#pragma unroll
            for (int w = 0; w < 4; ++w) s += qv[c * 8 + 2 * w] * bflo(kk[w]) + qv[c * 8 + 2 * w + 1] * bfhi(kk[w]); }
        if (s > mx) { const float f = exp2f(mx - s); l *= f;
#pragma unroll
            for (int e = 0; e < 32; ++e) o[e] *= f;
            mx = s; }
        const float p = exp2f(s - mx); l += p;
#pragma unroll
        for (int c = 0; c < 4; ++c) { const u32x4 vv = *(const u32x4*)(tb + v_img_off(kvr, eq * 32 + c * 8));
#pragma unroll
            for (int w = 0; w < 4; ++w) { o[c * 8 + 2 * w] += p * bflo(vv[w]); o[c * 8 + 2 * w + 1] += p * bfhi(vv[w]); } }
    }
    float* TMPF = (float*)(P.ws + WS_H);
    const float rl = 1.f / l;
#pragma unroll
    for (int e = 0; e < 32; ++e) TMPF[((size_t)((b * NH + h) * SEQ + q) * 2 + m) * DV + eq * 32 + e] = o[e] * rl;
}
__global__ void __launch_bounds__(256) nk_attn_fin(Ptrs P) {
    const int gw = blockIdx.x * 4 + (threadIdx.x >> 6), lane = threadIdx.x & 63;
    const int q = gw & 4095, h = (gw >> 12) & 3, b = gw >> 14;
    const float lam = lam_value(P);
    const float* TMPF = (const float*)(P.ws + WS_H) + (size_t)gw * 2 * DV;
    const float d0 = TMPF[lane * 2] - lam * TMPF[DV + lane * 2], d1 = TMPF[lane * 2 + 1] - lam * TMPF[DV + lane * 2 + 1];
    const float rstd = rsqrtf(wave_sum(d0 * d0 + d1 * d1) * (1.f / DV) + EPS) * (1.f - LAMBDA_INIT);
    bf16* AT = (bf16*)(P.ws + WS_ATTN);
    *(unsigned*)(AT + (size_t)(b * SEQ + q) * AW + h * DV + lane * 2) = pk2(d0 * rstd * P.subln_w[lane * 2], d1 * rstd * P.subln_w[lane * 2 + 1]);
}
__global__ void __launch_bounds__(256) nk_merge(Ptrs P) {
    __shared__ float ar[4][AW]; __shared__ float cr[4][CW];
    const int t0 = blockIdx.x * 4, tid = threadIdx.x;
    const bf16* AT = (const bf16*)(P.ws + WS_ATTN); const bf16* CF = (const bf16*)(P.ws + WS_CF);
    for (int i = tid; i < 4 * AW; i += 256) { ar[i >> 9][i & 511] = bf2f(AT[(size_t)t0 * AW + i]); cr[i >> 9][i & 511] = bf2f(CF[(size_t)t0 * CW + i]); }
    __syncthreads();
    const bf16* SG = (const bf16*)P.out; bf16* MG = (bf16*)(P.ws + WS_MG);
    for (int n = tid; n < DM; n += 256) {
        float a[4] = {0.f, 0.f, 0.f, 0.f}, c[4] = {0.f, 0.f, 0.f, 0.f};
        for (int k = 0; k < AW; ++k) { const float wa = P.w_pa[(size_t)k * DM + n], wb = P.w_pb[(size_t)k * DM + n];
#pragma unroll
            for (int r = 0; r < 4; ++r) { a[r] += ar[r][k] * wa; c[r] += cr[r][k] * wb; } }
#pragma unroll
        for (int r = 0; r < 4; ++r) { const size_t o = (size_t)(t0 + r) * DM + n;
            MG[o] = (bf16)f2bf(bf2f(SG[o]) * a[r] + bf2f(SG[(size_t)NTOK * DM + o]) * c[r]); }
    }
}
__global__ void __launch_bounds__(256) nk_wo(Ptrs P) {
    __shared__ float ar[4][DM];
    const int t0 = blockIdx.x * 4, tid = threadIdx.x;
    const bf16* MG = (const bf16*)(P.ws + WS_MG);
    for (int i = tid; i < 4 * DM; i += 256) ar[i >> 10][i & 1023] = bf2f(MG[(size_t)t0 * DM + i]);
    __syncthreads();
    float* H = (float*)(P.ws + WS_H);
    for (int n = tid; n < DM; n += 256) {
        float a[4] = {0.f, 0.f, 0.f, 0.f};
        for (int k = 0; k < DM; ++k) { const float w = P.w_o[(size_t)k * DM + n];
#pragma unroll
            for (int r = 0; r < 4; ++r) a[r] += ar[r][k] * w; }
#pragma unroll
        for (int r = 0; r < 4; ++r) { const size_t o = (size_t)(t0 + r) * DM + n; H[o] = P.x[o] + a[r]; }
    }
}
__global__ void __launch_bounds__(512) nk_hn(Ptrs P) { p5_hn(P, blockIdx.x * 8 + (threadIdx.x >> 6), gridDim.x * 8, threadIdx.x & 63); }
__global__ void __launch_bounds__(256) nk_wq(Ptrs P) {
    __shared__ float ar[4][DM];
    const int t0 = blockIdx.x * 4, tid = threadIdx.x;
    const bf16* HN = (const bf16*)(P.ws + WS_HN);
    for (int i = tid; i < 4 * DM; i += 256) ar[i >> 10][i & 1023] = bf2f(HN[(size_t)t0 * DM + i]);
    __syncthreads();
    bf16* QP = (bf16*)(P.ws + WS_QP);
    for (int n = tid; n < QPW; n += 256) {
        float a[4] = {0.f, 0.f, 0.f, 0.f};
        for (int k = 0; k < DM; ++k) { const float w = P.w_query[(size_t)k * QPW + n];
#pragma unroll
            for (int r = 0; r < 4; ++r) a[r] += ar[r][k] * w; }
#pragma unroll
        for (int r = 0; r < 4; ++r) QP[(size_t)(t0 + r) * QPW + n] = (bf16)f2bf(a[r]);
    }
}
__device__ __forceinline__ unsigned f2h(float f) { _Float16 h = (_Float16)f; return (unsigned)__builtin_bit_cast(unsigned short, h); }
__device__ __forceinline__ float h2f(unsigned u) { return (float)__builtin_bit_cast(_Float16, (unsigned short)(u & 0xffffu)); }
__global__ void __launch_bounds__(64) nk_topk(Ptrs P) {
    extern __shared__ __attribute__((aligned(16))) unsigned char ldsraw[];
    float* sc = (float*)ldsraw + threadIdx.x * 256;
    float* tv = (float*)ldsraw + 64 * 256 + threadIdx.x * 32;
    int* ti = (int*)((float*)ldsraw + 64 * 256 + 64 * 32) + threadIdx.x * 32;
    const int gid = blockIdx.x * 64 + threadIdx.x, t = gid >> 3, hd = gid & 7;
    const bf16* QP = (const bf16*)(P.ws + WS_QP) + (size_t)t * QPW + hd * 256;
    for (int p = 0; p < 2; ++p)
        for (int n = 0; n < NKEY; ++n) { const float* key = P.sub_keys + ((size_t)(hd * 2 + p) * NKEY + n) * PHD; float s = 0.f;
            for (int d = 0; d < PHD; ++d) s += bf2f(QP[p * 128 + d]) * key[d];
            sc[p * 128 + n] = s; }
    for (int p = 0; p < 2; ++p)
        for (int r = 0; r < TOPK; ++r) { float best = -3e38f; int bi = 0;
            for (int n = 0; n < NKEY; ++n) { const float v = sc[p * 128 + n]; if (v > best) { best = v; bi = n; } }
            tv[p * 16 + r] = best; ti[p * 16 + r] = bi; sc[p * 128 + bi] = -3e38f; }
    for (int i = 0; i < 16; ++i) for (int j = 0; j < 16; ++j) sc[i * 16 + j] = tv[i] + tv[16 + j];
    float top[16]; int eid[16];
#pragma unroll
    for (int r = 0; r < TOPK; ++r) { float best = -3e38f; int bi = 0;
        for (int n = 0; n < 256; ++n) { const float v = sc[n]; if (v > best) { best = v; bi = n; } }
        top[r] = best; eid[r] = ti[bi >> 4] * NKEY + ti[16 + (bi & 15)]; sc[bi] = -3e38f; }
    float sum = 0.f; const float tmax = top[0];
#pragma unroll
    for (int r = 0; r < TOPK; ++r) { top[r] = expf(top[r] - tmax); sum += top[r]; }
    unsigned* SEL = (unsigned*)(P.ws + WS_SEL) + (size_t)t * 128 + hd * 16;
#pragma unroll
    for (int r = 0; r < TOPK; ++r) SEL[r] = ((unsigned)eid[r] << 16) | f2h(top[r] / sum);
}
__global__ void __launch_bounds__(256) nk_peer(Ptrs P) {
    __shared__ float hn[DM]; __shared__ float wk[128]; __shared__ int ek[128]; __shared__ float red[4];
    const int t = blockIdx.x, tid = threadIdx.x;
    const bf16* HN = (const bf16*)(P.ws + WS_HN) + (size_t)t * DM;
    for (int i = tid; i < DM; i += 256) hn[i] = bf2f(HN[i]);
    __syncthreads();
    if (tid < 128) { const unsigned s = ((const unsigned*)(P.ws + WS_SEL))[(size_t)t * 128 + tid]; const int e = s >> 16; const float g = h2f(s);
        const float* u = P.expert_u + (size_t)e * DM; float a = 0.f;
        for (int d = 0; d < DM; ++d) a += u[d] * hn[d];
        const float ge = 0.5f * a * (1.f + erff(a * 0.70710678118654752f));
        wk[tid] = g * ge; ek[tid] = e; }
    __syncthreads();
    const float* H = (const float*)(P.ws + WS_H) + (size_t)t * DM;
    float y[4]; float ss = 0.f;
#pragma unroll
    for (int r = 0; r < 4; ++r) { const int d = tid + 256 * r; float o = 0.f;
        for (int k = 0; k < 128; ++k) o += wk[k] * P.expert_v[(size_t)ek[k] * DM + d];
        y[r] = H[d] + o; ss += y[r] * y[r]; }
    ss = wave_sum(ss);
    if ((tid & 63) == 0) red[tid >> 6] = ss;
    __syncthreads();
    const float rstd = rsqrtf((red[0] + red[1] + red[2] + red[3]) * (1.f / DM) + EPS);
#pragma unroll
    for (int r = 0; r < 4; ++r) { const int d = tid + 256 * r; P.out[(size_t)t * DM + d] = y[r] * rstd * P.final_norm_w[d]; }
}
namespace pg8 {
#define PG8_LAS __attribute__((address_space(3)))
typedef unsigned short bf16_t;
typedef short bf16x8 __attribute__((ext_vector_type(8)));
typedef float f32x4 __attribute__((ext_vector_type(4)));
typedef unsigned u32x4 __attribute__((ext_vector_type(4)));
constexpr int BM = 256, BK = 64, HALF = 128, HTB = HALF * BK * 2  , STAGE_BYTES = 8 * HTB, NXCD = 8, WGM = 8;

__host__ __device__ __forceinline__ int lds_byte(int r, int c) { const int st = (r >> 4) * 2 + (c >> 5), rr = r & 15, cc = c & 31, ob = rr * 64 + cc * 2; return st * 1024 + (ob ^ (((ob >> 9) & 1) << 5)); }
__host__ __device__ __forceinline__ void stage_rc(int b, int& R, int& C) { const int st = b / 1024, sb = b % 1024, swz = sb ^ (((sb >> 9) & 1) << 5); R = (st >> 1) * 16 + swz / 64; C = (st & 1) * 32 + (swz % 64) / 2; }
__host__ __device__ __forceinline__ int perm32(int rho) { const int n = rho >> 4, i = rho & 15; return 8 * (i >> 2) + 4 * n + (i & 3); }

struct Unit { int pm, pn; };
struct Gemm { const bf16_t* A; const bf16_t* Bt; int M, N, K; };

struct StaticOrder {
    int nM, nN, nwg, G, c;
    __host__ __device__ void init(int M, int N, int G_, int c_) { nM = M / BM; nN = N / BM; nwg = nM * nN; G = G_; c = c_; }
    __host__ __device__ bool next(int i, Unit& u) const {
        const long L = (long)i * G + c; if (L >= nwg) return false;
        int wgid = (int)L; { const int q = nwg / NXCD, r = nwg % NXCD, xcd = wgid % NXCD, off = wgid / NXCD; wgid = (xcd < r ? xcd * (q + 1) : r * (q + 1) + (xcd - r) * q) + off; }
        const int nig = WGM * nN, gid = wgid / nig, fm = gid * WGM, gsz = (nM - fm) < WGM ? (nM - fm) : WGM;
        u.pm = fm + ((wgid % nig) % gsz); u.pn = (wgid % nig) / gsz; return true;
    }
    __device__ __forceinline__ void a_ready(const Unit&) const {}
    __device__ __forceinline__ void done(const Unit&) const {}
};

__device__ __forceinline__ unsigned cvt_pk_bf16(float lo, float hi) { unsigned r; asm volatile("v_cvt_pk_bf16_f32 %0, %1, %2" : "=v"(r) : "v"(lo), "v"(hi)); return r; }
template <class Epi, class Sched, bool ALIGN_EPI = false, bool SP2 = false>
__device__ __forceinline__ void gemm_phase(PG8_LAS unsigned char* lds, const Gemm g, const Sched& S, const Epi& E) {
    const int tid = threadIdx.x, wid = __builtin_amdgcn_readfirstlane(tid >> 6), lane = tid & 63, wr = wid >> 2, wc = wid & 3, fr = lane & 15, fq = lane >> 4;
    const int K = g.K, nt = K / BK;
    unsigned voffA[2], voffB[2];
#pragma unroll
    for (int i = 0; i < 2; ++i) { int R, C; stage_rc(tid * 16 + i * 8192, R, C); const int Rb = Epi::PERM ? ((R & ~31) + perm32(R & 31)) : R;
        voffA[i] = (unsigned)(R * K + C) * 2u; voffB[i] = (unsigned)(Rb * K + C) * 2u; }
    const size_t kstep = (size_t)(BK * 2);
    const size_t hstep = (size_t)HALF * K * 2;
    const size_t tstep = 2 * hstep;
    const unsigned ldsw = (unsigned)wid * 1024u;
    const int aoff = lds_byte(wr * 64 + fr, fq * 8), boff = lds_byte(wc * 32 + fr, fq * 8);
#define PG8_SA(b, h) (((b) * 2 + (h)) * HTB)
#define PG8_SB(b, h) ((4 + (b) * 2 + (h)) * HTB)
#define PG8_STAGE(bufoff, gbase, voff) do { _Pragma("unroll") for (int _i = 0; _i < 2; ++_i) \
        __builtin_amdgcn_global_load_lds((const unsigned*)((const char*)(gbase) + (voff)[_i]), (PG8_LAS unsigned*)(lds + (bufoff) + ldsw + _i * 8192), 16, 0, 0); } while (0)
#define PG8_LDA(dst, b, h) do { _Pragma("unroll") for (int m = 0; m < 4; ++m) _Pragma("unroll") for (int k = 0; k < 2; ++k) dst[m][k] = *(const PG8_LAS bf16x8*)(lds + PG8_SA(b, h) + aoff + m * 2048 + k * 1024); } while (0)
#define PG8_LDB(dst, b, h) do { _Pragma("unroll") for (int n = 0; n < 2; ++n) _Pragma("unroll") for (int k = 0; k < 2; ++k) dst[n][k] = *(const PG8_LAS bf16x8*)(lds + PG8_SB(b, h) + boff + n * 2048 + k * 1024); } while (0)
#define PG8_MMA(ai, bj, At, Bt) do { __builtin_amdgcn_s_setprio(1); _Pragma("unroll") for (int m = 0; m < 4; ++m) _Pragma("unroll") for (int n = 0; n < 2; ++n) _Pragma("unroll") for (int k = 0; k < 2; ++k) \
        acc[ai][bj][m][n] = __builtin_amdgcn_mfma_f32_16x16x32_bf16(Bt[n][k], At[m][k], acc[ai][bj][m][n], 0, 0, 0); __builtin_amdgcn_s_setprio(0); } while (0)
#define PG8_WAIT_V(n) asm volatile("s_waitcnt vmcnt(" #n ")" ::: "memory")
#define PG8_WAIT_L(n) asm volatile("s_waitcnt lgkmcnt(" #n ")" ::: "memory")
#define PG8_BAR __builtin_amdgcn_s_barrier()
#define PG8_SCHED __builtin_amdgcn_sched_barrier(0)
    Unit cur, nxt; int ui = 0;
    if (!S.next(0, cur)) return;
    f32x4 acc[2][2][4][2];
#pragma unroll
    for (int a = 0; a < 2; ++a)
#pragma unroll
        for (int b = 0; b < 2; ++b)
#pragma unroll
            for (int m = 0; m < 4; ++m)
#pragma unroll
                for (int n = 0; n < 2; ++n) acc[a][b][m][n] = (f32x4){0.f, 0.f, 0.f, 0.f};
    bf16x8 At[4][2], B0[2][2], B1[2][2];
    const char* cA = (const char*)g.A + (size_t)cur.pm * tstep; const char* cB = (const char*)g.Bt + (size_t)cur.pn * tstep;
    S.a_ready(cur);
    if constexpr (SP2) {
        PG8_STAGE(PG8_SB(0, 0), cB, voffB); PG8_STAGE(PG8_SB(0, 1), cB + hstep, voffB); PG8_STAGE(PG8_SA(0, 0), cA, voffA); PG8_STAGE(PG8_SA(0, 1), cA + hstep, voffA);
        if (wr == 1) PG8_BAR;
        PG8_WAIT_V(2); PG8_BAR;
        PG8_STAGE(PG8_SB(1, 0), cB + kstep, voffB); PG8_STAGE(PG8_SA(1, 0), cA + kstep, voffA); PG8_STAGE(PG8_SB(1, 1), cB + hstep + kstep, voffB);
        PG8_WAIT_V(6); PG8_BAR;
    } else {
        PG8_STAGE(PG8_SB(0, 0), cB, voffB); PG8_STAGE(PG8_SA(0, 0), cA, voffA); PG8_STAGE(PG8_SB(0, 1), cB + hstep, voffB); PG8_STAGE(PG8_SA(0, 1), cA + hstep, voffA);
        if (wr == 1) PG8_BAR;
        PG8_WAIT_V(4); PG8_BAR;
        PG8_STAGE(PG8_SB(1, 0), cB + kstep, voffB); PG8_STAGE(PG8_SA(1, 0), cA + kstep, voffA); PG8_STAGE(PG8_SB(1, 1), cB + hstep + kstep, voffB);
        PG8_WAIT_V(6); PG8_BAR;
    }
    for (;;) {
        const bool has_next = S.next(ui + 1, nxt);
        const char* nA = has_next ? (const char*)g.A + (size_t)nxt.pm * tstep : cA; const char* nB = has_next ? (const char*)g.Bt + (size_t)nxt.pn * tstep : cB;
        for (int t = 0; t < nt; t += 2) {
            const bool last = (t == nt - 2);
            const char* a1 = cA + (size_t)(t + 1) * kstep;
            const char* a2 = last ? nA : cA + (size_t)(t + 2) * kstep; const char* b2 = last ? nB : cB + (size_t)(t + 2) * kstep;
            const char* a3 = a2 + kstep; const char* b3 = b2 + kstep;
            if (last && has_next) S.a_ready(nxt);
            if constexpr (SP2) {
            PG8_LDB(B0, 0, 0); PG8_LDB(B1, 0, 1); PG8_SCHED; PG8_LDA(At, 0, 0); PG8_STAGE(PG8_SA(1, 1), a1 + hstep, voffA);
            PG8_WAIT_V(8); PG8_WAIT_L(0); PG8_BAR; PG8_MMA(0, 0, At, B0); PG8_MMA(0, 1, At, B1); PG8_BAR; PG8_SCHED;
            PG8_LDA(At, 0, 1); PG8_STAGE(PG8_SB(0, 0), b2, voffB); PG8_STAGE(PG8_SB(0, 1), b2 + hstep, voffB); PG8_STAGE(PG8_SA(0, 0), a2, voffA);
            PG8_WAIT_V(8); PG8_WAIT_L(0); PG8_BAR; PG8_MMA(1, 0, At, B0); PG8_MMA(1, 1, At, B1); PG8_BAR; PG8_SCHED;
            PG8_LDB(B0, 1, 0); PG8_LDB(B1, 1, 1); PG8_SCHED; PG8_LDA(At, 1, 0); PG8_STAGE(PG8_SA(0, 1), a2 + hstep, voffA);
            PG8_WAIT_V(8); PG8_WAIT_L(0); PG8_BAR; PG8_MMA(0, 0, At, B0); PG8_MMA(0, 1, At, B1); PG8_BAR; PG8_SCHED;
            PG8_LDA(At, 1, 1); PG8_STAGE(PG8_SB(1, 0), b3, voffB); PG8_STAGE(PG8_SB(1, 1), b3 + hstep, voffB); PG8_STAGE(PG8_SA(1, 0), a3, voffA);
            PG8_WAIT_V(8); PG8_WAIT_L(0); PG8_BAR; PG8_MMA(1, 0, At, B0); PG8_MMA(1, 1, At, B1); PG8_BAR; PG8_SCHED;
            } else {
            PG8_LDB(B0, 0, 0); PG8_SCHED; PG8_LDA(At, 0, 0); PG8_STAGE(PG8_SA(1, 1), a1 + hstep, voffA);
            PG8_WAIT_L(8); PG8_BAR; PG8_WAIT_L(0); PG8_MMA(0, 0, At, B0); PG8_BAR; PG8_SCHED;
            PG8_LDB(B1, 0, 1); PG8_STAGE(PG8_SB(0, 0), b2, voffB);
            PG8_BAR; PG8_WAIT_L(0); PG8_MMA(0, 1, At, B1); PG8_BAR;
            PG8_LDA(At, 0, 1); PG8_STAGE(PG8_SA(0, 0), a2, voffA);
            PG8_BAR; PG8_WAIT_L(0); PG8_MMA(1, 0, At, B0); PG8_BAR; PG8_SCHED;
            PG8_STAGE(PG8_SB(0, 1), b2 + hstep, voffB);
            PG8_WAIT_V(6); PG8_BAR; PG8_MMA(1, 1, At, B1); PG8_BAR;
            PG8_LDB(B0, 1, 0); PG8_SCHED; PG8_LDA(At, 1, 0); PG8_STAGE(PG8_SA(0, 1), a2 + hstep, voffA);
            PG8_WAIT_L(8); PG8_BAR; PG8_WAIT_L(0); PG8_MMA(0, 0, At, B0); PG8_BAR; PG8_SCHED;
            PG8_LDB(B1, 1, 1); PG8_STAGE(PG8_SB(1, 0), b3, voffB);
            PG8_BAR; PG8_WAIT_L(0); PG8_MMA(0, 1, At, B1); PG8_BAR;
            PG8_LDA(At, 1, 1); PG8_STAGE(PG8_SA(1, 0), a3, voffA);
            PG8_BAR; PG8_WAIT_L(0); PG8_MMA(1, 0, At, B0); PG8_BAR; PG8_SCHED;
            PG8_STAGE(PG8_SB(1, 1), b3 + hstep, voffB);
            PG8_WAIT_V(6); PG8_BAR; PG8_MMA(1, 1, At, B1); PG8_BAR;
            }
        }
        if constexpr (ALIGN_EPI) { if (wr == 0) PG8_BAR; }
        if constexpr (!Epi::AFTER_DRAIN) { E(acc, cur, wr, wc, fr, fq); S.done(cur); }
        if (!has_next) break;
#pragma unroll
        for (int a = 0; a < 2; ++a)
#pragma unroll
            for (int b = 0; b < 2; ++b)
#pragma unroll
                for (int m = 0; m < 4; ++m)
#pragma unroll
                    for (int n = 0; n < 2; ++n) acc[a][b][m][n] = (f32x4){0.f, 0.f, 0.f, 0.f};
        cur = nxt; cA = nA; cB = nB; ++ui;
        if constexpr (ALIGN_EPI) { if (wr == 1) PG8_BAR; }
    }
    PG8_WAIT_V(0);
    if constexpr (!ALIGN_EPI) { if (wr == 0) PG8_BAR; }
    PG8_BAR;
    if constexpr (Epi::AFTER_DRAIN) { E.fused(acc, cur, wr, wc, fr, fq, lds, wid, lane); S.done(cur); }
#undef PG8_SA
#undef PG8_SB
#undef PG8_STAGE
#undef PG8_LDA
#undef PG8_LDB
#undef PG8_MMA
#undef PG8_WAIT_V
#undef PG8_WAIT_L
#undef PG8_BAR
#undef PG8_SCHED
}
}
namespace pg8 {
__device__ __forceinline__ float fast_sigmoid(float v) { return __builtin_amdgcn_rcpf(1.f + __expf(-v)); }
struct EpiInProj {
    static constexpr bool PERM = true, AFTER_DRAIN = false;
    unsigned char* ws; bf16_t* sg; const float* COS; const float* SIN;
    __device__ __forceinline__ void operator()(const f32x4 (&acc)[2][2][4][2], const Unit& u, int wr, int wc, int fr, int fq) const {
        const int pn = u.pn, row0 = u.pm * BM + wr * 64 + fr, cw = wc * 32 + 8 * fq;
#pragma unroll
        for (int ai = 0; ai < 2; ++ai)
#pragma unroll
            for (int m = 0; m < 4; ++m) {
                const int row = row0 + ai * HALF + m * 16, bb = row >> 12, pos = row & 4095, tile = pos >> 6, kvr = pos & 63;
                if (pn < 4) {
                    const int i0 = (cw & 63) >> 1;
                    const f32x4 cs = *(const f32x4*)(COS + pos * 32 + i0), sn = *(const f32x4*)(SIN + pos * 32 + i0);
#pragma unroll
                    for (int bj = 0; bj < 2; ++bj) {
                        const f32x4 v0 = acc[ai][bj][m][0], v1 = acc[ai][bj][m][1];
                        float o[8];
                        o[0] = v0[0] * cs[0] - v0[1] * sn[0]; o[1] = v0[1] * cs[0] + v0[0] * sn[0];
                        o[2] = v0[2] * cs[1] - v0[3] * sn[1]; o[3] = v0[3] * cs[1] + v0[2] * sn[1];
                        o[4] = v1[0] * cs[2] - v1[1] * sn[2]; o[5] = v1[1] * cs[2] + v1[0] * sn[2];
                        o[6] = v1[2] * cs[3] - v1[3] * sn[3]; o[7] = v1[3] * cs[3] + v1[2] * sn[3];
                        const int cq = (pn & 1) * 256 + bj * HALF + cw;
                        u32x4 w;
                        if (pn < 2) { w.x = cvt_pk_bf16(o[0] * C2, o[1] * C2); w.y = cvt_pk_bf16(o[2] * C2, o[3] * C2); w.z = cvt_pk_bf16(o[4] * C2, o[5] * C2); w.w = cvt_pk_bf16(o[6] * C2, o[7] * C2);
                            *(u32x4*)((bf16_t*)(ws + WS_Q) + (size_t)row * QKW + cq) = w; }
                        else { w.x = cvt_pk_bf16(o[0], o[1]); w.y = cvt_pk_bf16(o[2], o[3]); w.z = cvt_pk_bf16(o[4], o[5]); w.w = cvt_pk_bf16(o[6], o[7]);
                            const int g = cq >> 6; *(u32x4*)(ws + WS_KV + kv_tile_off(bb, g >> 1, tile) + k_img_off(g & 1, kvr, cq & 63)) = w; }
                    }
                } else {
#pragma unroll
                    for (int bj = 0; bj < 2; ++bj) {
                        f32x4 v0 = acc[ai][bj][m][0], v1 = acc[ai][bj][m][1];
                        if (pn >= 12) {
#pragma unroll
                            for (int q = 0; q < 4; ++q) { v0[q] = fast_sigmoid(v0[q]); v1[q] = fast_sigmoid(v1[q]); } }
                        u32x4 w; w.x = cvt_pk_bf16(v0[0], v0[1]); w.y = cvt_pk_bf16(v0[2], v0[3]); w.z = cvt_pk_bf16(v1[0], v1[1]); w.w = cvt_pk_bf16(v1[2], v1[3]);
                        if (pn < 6) { const int ce = (pn - 4) * 256 + bj * HALF + cw; *(u32x4*)(ws + WS_KV + kv_tile_off(bb, ce >> 7, tile) + v_img_off(kvr, ce & 127)) = w; }
                        else if (pn < 12) { const int jj = (pn - 6) * 256 + bj * HALF + cw, which = jj >> 9, cc = jj & 511;
                            *(u32x4*)((bf16_t*)(ws + (which == 0 ? WS_BG : which == 1 ? WS_CG : WS_XC)) + (size_t)row * CW + cc) = w; }
                        else { const int jj = (pn - 12) * 256 + bj * HALF + cw, which = jj >> 10, cc = jj & 1023;
                            *(u32x4*)(sg + (size_t)which * NTOK * DM + (size_t)row * DM + cc) = w; }
                    }
                }
            }
    }
};
template <int SECOND> struct EpiGate {
    static constexpr bool PERM = true, AFTER_DRAIN = false;
    const bf16_t* gate; const bf16_t* prev; bf16_t* O;
    __device__ __forceinline__ void operator()(const f32x4 (&acc)[2][2][4][2], const Unit& u, int wr, int wc, int fr, int fq) const {
        const int row0 = u.pm * BM + wr * 64 + fr, col0 = u.pn * BM + wc * 32 + 8 * fq;
#pragma unroll
        for (int ai = 0; ai < 2; ++ai)
#pragma unroll
            for (int m = 0; m < 4; ++m) {
                const size_t ro = (size_t)(row0 + ai * HALF + m * 16) * DM + col0;
#pragma unroll
                for (int bj = 0; bj < 2; ++bj) {
                    const f32x4 v0 = acc[ai][bj][m][0], v1 = acc[ai][bj][m][1];
                    const u32x4 g = *(const u32x4*)(gate + ro + bj * HALF);
                    float o[8];
                    o[0] = bflo(g.x) * v0[0]; o[1] = bfhi(g.x) * v0[1]; o[2] = bflo(g.y) * v0[2]; o[3] = bfhi(g.y) * v0[3];
                    o[4] = bflo(g.z) * v1[0]; o[5] = bfhi(g.z) * v1[1]; o[6] = bflo(g.w) * v1[2]; o[7] = bfhi(g.w) * v1[3];
                    if (SECOND) { const u32x4 p = *(const u32x4*)(prev + ro + bj * HALF);
                        o[0] += bflo(p.x); o[1] += bfhi(p.x); o[2] += bflo(p.y); o[3] += bfhi(p.y); o[4] += bflo(p.z); o[5] += bfhi(p.z); o[6] += bflo(p.w); o[7] += bfhi(p.w); }
                    u32x4 w; w.x = cvt_pk_bf16(o[0], o[1]); w.y = cvt_pk_bf16(o[2], o[3]); w.z = cvt_pk_bf16(o[4], o[5]); w.w = cvt_pk_bf16(o[6], o[7]);
                    *(u32x4*)(O + ro + bj * HALF) = w;
                }
            }
    }
};
struct EpiResid {
    static constexpr bool PERM = false, AFTER_DRAIN = false;
    const float* base; float* C;
    __device__ __forceinline__ void operator()(const f32x4 (&acc)[2][2][4][2], const Unit& u, int wr, int wc, int fr, int fq) const {
        const int row0 = u.pm * BM + wr * 64 + fr, col0 = u.pn * BM + wc * 32 + 4 * fq;
#pragma unroll
        for (int ai = 0; ai < 2; ++ai)
#pragma unroll
            for (int m = 0; m < 4; ++m) { const size_t ro = (size_t)(row0 + ai * HALF + m * 16) * DM + col0;
#pragma unroll
                for (int bj = 0; bj < 2; ++bj)
#pragma unroll
                    for (int n = 0; n < 2; ++n) *(f32x4*)(C + ro + bj * HALF + n * 16) = acc[ai][bj][m][n] + *(const f32x4*)(base + ro + bj * HALF + n * 16); }
    }
};
struct EpiPlainBf16 {
    static constexpr bool PERM = true, AFTER_DRAIN = false;
    bf16_t* O; int ldc;
    __device__ __forceinline__ void operator()(const f32x4 (&acc)[2][2][4][2], const Unit& u, int wr, int wc, int fr, int fq) const {
        const int row0 = u.pm * BM + wr * 64 + fr, col0 = u.pn * BM + wc * 32 + 8 * fq;
#pragma unroll
        for (int ai = 0; ai < 2; ++ai)
#pragma unroll
            for (int m = 0; m < 4; ++m) { bf16_t* rowp = O + (size_t)(row0 + ai * HALF + m * 16) * ldc + col0;
#pragma unroll
                for (int bj = 0; bj < 2; ++bj) { const f32x4 v0 = acc[ai][bj][m][0], v1 = acc[ai][bj][m][1];
                    u32x4 w; w.x = cvt_pk_bf16(v0[0], v0[1]); w.y = cvt_pk_bf16(v0[2], v0[3]); w.z = cvt_pk_bf16(v1[0], v1[1]); w.w = cvt_pk_bf16(v1[2], v1[3]);
                    *(u32x4*)(rowp + bj * HALF) = w; } }
    }
};
}

constexpr int NWAVES = 8;
constexpr int RING_BYTES = 131072, LDSCTL_OFF = RING_BYTES, MISC_OFF = LDSCTL_OFF + 320, LDS_BYTES = 147456;
constexpr int CW_BAR = 4096;
#define RLX_AGENT __ATOMIC_RELAXED, __HIP_MEMORY_SCOPE_AGENT
#define XB_TMO      128
#define XB_XCNT(j)  (256  + 64 * (j))
#define XB_XSUB(j)  (1280 + 64 * (j))
#define XB_XGEN(j)  (2304 + 64 * (j))
#define XB_TOP      3328
#define XB_TOPGEN   3392
#define XCD_BAR_WORDS 3456
#define XB_SPIN_CAP (1u << 18)

__device__ __forceinline__ unsigned xb_ld(unsigned* p)              { return __hip_atomic_load(p, __ATOMIC_RELAXED, __HIP_MEMORY_SCOPE_AGENT); }
__device__ __forceinline__ unsigned xb_add(unsigned* p, unsigned v) { return __hip_atomic_fetch_add(p, v, __ATOMIC_RELAXED, __HIP_MEMORY_SCOPE_AGENT); }
__device__ __forceinline__ unsigned xb_xcc_id() { return (unsigned)__builtin_amdgcn_s_getreg((3 << 11) | 20) & 0xFu; }
#define XB_SPIN(cond, bar) do { unsigned _sp = 0; while (cond) { __builtin_amdgcn_s_sleep(1); \
    if ((++_sp & 255u) == 0u) { if (xb_ld(&(bar)[XB_TMO])) break; if (_sp > XB_SPIN_CAP) { atomicAdd(&(bar)[XB_TMO], 1u); break; } } } } while (0)

struct XcdBarrier {
    unsigned* bar; unsigned x;
    volatile LAS unsigned* st;
};

__device__ __forceinline__ XcdBarrier xcd_barrier_post(unsigned* bar, volatile LAS unsigned* st) {
    XcdBarrier b; b.bar = bar; b.x = xb_xcc_id(); b.st = st;
    if (threadIdx.x == 0) (void)xb_add(&bar[XB_XCNT(b.x)], 1u);
    return b;
}
__device__ __forceinline__ void xcd_barrier_complete(unsigned* bar, unsigned x, unsigned& nloc, unsigned& nx) {
    const unsigned G = gridDim.x * gridDim.y * gridDim.z;
    unsigned sum, cnt, mine, sp = 0u;
    for (;;) {
        sum = 0u; cnt = 0u; mine = 0u;
#pragma unroll
        for (unsigned j = 0; j < 16; ++j) { const unsigned c = xb_ld(&bar[XB_XCNT(j)]); sum += c; cnt += (c > 0u) ? 1u : 0u; mine = (j == x) ? c : mine; }
        if (sum == G) break;
        __builtin_amdgcn_s_sleep(1);
        if ((++sp & 255u) == 0u) { if (xb_ld(&bar[XB_TMO])) break; if (sp > XB_SPIN_CAP) { atomicAdd(&bar[XB_TMO], 1u); break; } }
    }
    nloc = mine > 0u ? mine : 1u; nx = cnt > 0u ? cnt : 1u;
}

__device__ __forceinline__ void xcd_barrier(const XcdBarrier& b) {
    asm volatile("s_waitcnt vmcnt(0)" ::: "memory");
    __syncthreads();
    if (threadIdx.x == 0) {
        unsigned* bar = b.bar;
        __builtin_amdgcn_s_waitcnt(0);
        unsigned nloc = b.st[0], nx = b.st[1];
        if (nloc == 0u) { xcd_barrier_complete(bar, b.x, nloc, nx); b.st[0] = nloc; b.st[1] = nx; }
        const unsigned old = xb_add(&bar[XB_XSUB(b.x)], 1u);
        const unsigned gen = old / nloc;
        if (old + 1u == (gen + 1u) * nloc) {
            __builtin_amdgcn_fence(__ATOMIC_RELEASE, "agent");
            asm volatile("s_waitcnt vmcnt(0)" ::: "memory");
            const unsigned og = xb_add(&bar[XB_TOP], 1u);
            const unsigned tg = og / nx;
            if (og + 1u == (tg + 1u) * nx) xb_add(&bar[XB_TOPGEN], 1u);
            else XB_SPIN(xb_ld(&bar[XB_TOPGEN]) == tg, bar);
            __builtin_amdgcn_fence(__ATOMIC_ACQUIRE, "agent");
            xb_add(&bar[XB_XGEN(b.x)], 1u);
            asm volatile("s_waitcnt vmcnt(0)" ::: "memory");
        } else {
            XB_SPIN(xb_ld(&bar[XB_XGEN(b.x)]) == gen, bar);
            __builtin_amdgcn_fence(__ATOMIC_ACQUIRE, "agent");
            asm volatile("s_waitcnt vmcnt(0)" ::: "memory");
        }
    }
    __syncthreads();
}
namespace att {
typedef short v4i16_t __attribute__((ext_vector_type(4)));
constexpr int KVBUF = 32768, QF_OFF = 2 * KVBUF, WSF_OFF = 131072 + 1024, OST_OFF = 0;
constexpr float THR = 8.0f;
__device__ __forceinline__ int crow(int r, int hi) { return (r & 3) + 8 * (r >> 2) + 4 * hi; }
__device__ __forceinline__ float halves_max(float v) { auto rr = __builtin_amdgcn_permlane32_swap(__float_as_uint(v), __float_as_uint(v), false, false); return fmaxf(__uint_as_float(rr[0]), __uint_as_float(rr[1])); }
__device__ __forceinline__ float halves_sum(float v) { auto rr = __builtin_amdgcn_permlane32_swap(__float_as_uint(v), __float_as_uint(v), false, false); return __uint_as_float(rr[0]) + __uint_as_float(rr[1]); }
__device__ __forceinline__ unsigned cvtpk(float lo, float hi) { typedef float f2 __attribute__((ext_vector_type(2))); typedef __bf16 b2 __attribute__((ext_vector_type(2))); f2 v = {lo, hi}; b2 b = __builtin_convertvector(v, b2); return __builtin_bit_cast(unsigned, b); }

__device__ __forceinline__ void attn_unit(const Ptrs& P, LAS unsigned char* L, int b, int h, int qb, float lam, int wave, int lane) {
    int r32 = lane & 31, hi = lane >> 5;
    const unsigned char* kvbase = P.ws + WS_KV + kv_tile_off(b, h, 0);
    LAS float* wsf = (LAS float*)(L + WSF_OFF) + wave * 64;
#define ATT_DMA(t, bufoff) do { _Pragma("unroll") for (int j_ = 0; j_ < 4; ++j_) { const int piece_ = wave * 4 + j_; \
        __builtin_amdgcn_global_load_lds((const unsigned*)(kvbase + (size_t)(t) * 32768 + piece_ * 1024 + lane * 16), (LAS unsigned*)(L + (bufoff) + piece_ * 1024), 16, 0, 0); } } while (0)
    ATT_DMA(0, 0);
    LAS unsigned char* qfl = L + QF_OFF + wave * 8192 + lane * 16;
    { const bf16* Qw = (const bf16*)(P.ws + WS_Q) + (size_t)(b * SEQ + qb * 256 + wave * 32 + r32) * QKW + h * 128 + hi * 8;
#pragma unroll
      for (int m = 0; m < 2; ++m)
#pragma unroll
          for (int d0 = 0; d0 < 4; ++d0) *(LAS bf16x8*)(qfl + (m * 4 + d0) * 1024) = *(const bf16x8*)(Qw + m * 64 + d0 * 16); }
    f32x16 o[2][4];
#pragma unroll
    for (int m = 0; m < 2; ++m)
#pragma unroll
        for (int k = 0; k < 4; ++k) o[m][k] = f32x16{};
    float mhat[2] = {-1e30f, -1e30f}, lsum[2] = {0.f, 0.f};
    const int vlane = 16384 + ((lane >> 4) & 1) * 32 + (lane & 3) * 8 + (4 * hi + ((lane & 15) >> 2)) * 64;
    asm volatile("s_waitcnt vmcnt(0)" ::: "memory"); __syncthreads();
    for (int t = 0; t < 64; ++t) {
        const int cur = (t & 1) * KVBUF;
        if (t + 1 < 64) ATT_DMA(t + 1, KVBUF - cur);
        bf16x8 pa[2][4];
#pragma unroll
        for (int m = 0; m < 2; ++m) {
            f32x16 p0 = f32x16{}, p1 = f32x16{};
            const LAS unsigned char* kb = L + cur + m * 8192 + hi * 1024 + r32 * 16;
#pragma unroll
            for (int d0 = 0; d0 < 4; ++d0) {
                const bf16x8 k0 = *(const LAS bf16x8*)(kb + d0 * 2048), k1 = *(const LAS bf16x8*)(kb + d0 * 2048 + 512);
                const bf16x8 q = *(const LAS bf16x8*)(qfl + (m * 4 + d0) * 1024);
                p0 = __builtin_amdgcn_mfma_f32_32x32x16_bf16(k0, q, p0, 0, 0, 0);
                p1 = __builtin_amdgcn_mfma_f32_32x32x16_bf16(k1, q, p1, 0, 0, 0);
            }
            float rm = fmaxf(p0[0], p1[0]);
#pragma unroll
            for (int r = 1; r < 16; ++r) rm = fmaxf(rm, fmaxf(p0[r], p1[r]));
            rm = halves_max(rm);
            if (__any(rm > mhat[m] + THR)) {
                const float mn = fmaxf(mhat[m], rm), f = __builtin_amdgcn_exp2f(mhat[m] - mn);
                mhat[m] = mn; lsum[m] *= f;
                if (hi == 0) wsf[r32] = f;
                asm volatile("s_waitcnt lgkmcnt(0)" ::: "memory");
#pragma unroll
                for (int r = 0; r < 16; ++r) { const float fr = wsf[crow(r, hi)];
#pragma unroll
                    for (int k = 0; k < 4; ++k) o[m][k][r] *= fr; }
                asm volatile("s_waitcnt lgkmcnt(0)" ::: "memory");
            }
            const float mh = mhat[m]; float ls = 0.f;
#pragma unroll
            for (int r = 0; r < 16; ++r) { p0[r] = __builtin_amdgcn_exp2f(p0[r] - mh); p1[r] = __builtin_amdgcn_exp2f(p1[r] - mh); ls += p0[r] + p1[r]; }
            lsum[m] += ls;
            { u32x4 w;
              w.x = cvtpk(p0[0], p0[1]); w.y = cvtpk(p0[2], p0[3]); w.z = cvtpk(p0[4], p0[5]); w.w = cvtpk(p0[6], p0[7]); pa[m][0] = __builtin_bit_cast(bf16x8, w);
              w.x = cvtpk(p0[8], p0[9]); w.y = cvtpk(p0[10], p0[11]); w.z = cvtpk(p0[12], p0[13]); w.w = cvtpk(p0[14], p0[15]); pa[m][1] = __builtin_bit_cast(bf16x8, w);
              w.x = cvtpk(p1[0], p1[1]); w.y = cvtpk(p1[2], p1[3]); w.z = cvtpk(p1[4], p1[5]); w.w = cvtpk(p1[6], p1[7]); pa[m][2] = __builtin_bit_cast(bf16x8, w);
              w.x = cvtpk(p1[8], p1[9]); w.y = cvtpk(p1[10], p1[11]); w.z = cvtpk(p1[12], p1[13]); w.w = cvtpk(p1[14], p1[15]); pa[m][3] = __builtin_bit_cast(bf16x8, w); }
        }
        { const LAS unsigned char* vb = L + cur + vlane;
#pragma unroll
          for (int blk = 0; blk < 4; ++blk)
#pragma unroll
              for (int ks = 0; ks < 4; ++ks) {
                  const v4i16_t lo = __builtin_amdgcn_ds_read_tr16_b64_v4i16((LAS v4i16_t*)(vb + blk * 4096 + ks * 1024));
                  const v4i16_t hv = __builtin_amdgcn_ds_read_tr16_b64_v4i16((LAS v4i16_t*)(vb + blk * 4096 + ks * 1024 + 512));
                  const bf16x8 vf = (bf16x8){lo[0], lo[1], lo[2], lo[3], hv[0], hv[1], hv[2], hv[3]};
                  o[0][blk] = __builtin_amdgcn_mfma_f32_32x32x16_bf16(pa[0][ks], vf, o[0][blk], 0, 0, 0);
                  o[1][blk] = __builtin_amdgcn_mfma_f32_32x32x16_bf16(pa[1][ks], vf, o[1][blk], 0, 0, 0);
              } }
        asm volatile("s_waitcnt vmcnt(0) lgkmcnt(0)" ::: "memory"); __syncthreads();
    }
#undef ATT_DMA
    asm volatile("" : "+v"(lane));
    r32 = lane & 31; hi = lane >> 5;
    const float l0 = halves_sum(lsum[0]), l1 = halves_sum(lsum[1]);
    if (hi == 0) { wsf[r32] = 1.f / l0; wsf[32 + r32] = lam / l1; }
    asm volatile("s_waitcnt lgkmcnt(0)" ::: "memory");
    float ss[16];
#pragma unroll
    for (int r = 0; r < 16; ++r) { const float a = wsf[crow(r, hi)], c = wsf[32 + crow(r, hi)]; float s = 0.f;
#pragma unroll
        for (int k = 0; k < 4; ++k) { const float d = o[0][k][r] * a - o[1][k][r] * c; o[0][k][r] = d; s += d * d; }
        ss[r] = s; }
#pragma unroll
    for (int r = 0; r < 16; ++r) {
#pragma unroll
        for (int x = 1; x < 32; x <<= 1) ss[r] += __shfl_xor(ss[r], x);
        ss[r] = rsqrtf(ss[r] * (1.f / DV) + EPS) * (1.f - LAMBDA_INIT); }
    LAS bf16* stg = (LAS bf16*)(L + OST_OFF) + wave * 4096;
#pragma unroll
    for (int k = 0; k < 4; ++k) { const float sw = P.subln_w[k * 32 + r32];
#pragma unroll
        for (int r = 0; r < 16; ++r) stg[crow(r, hi) * 128 + k * 32 + r32] = (bf16)f2bf(o[0][k][r] * ss[r] * sw); }
    asm volatile("s_waitcnt lgkmcnt(0)" ::: "memory");
    bf16* AT = (bf16*)(P.ws + WS_ATTN) + (size_t)(b * SEQ + qb * 256 + wave * 32) * AW + h * DV;
#pragma unroll
    for (int i = 0; i < 8; ++i) { const int row = i * 4 + (lane >> 4), ch = lane & 15;
        const u32x4 v = *(const LAS u32x4*)(stg + row * 128 + ch * 8); *(u32x4*)(AT + (size_t)row * AW + ch * 8) = v; }
    asm volatile("s_waitcnt lgkmcnt(0)" ::: "memory"); __syncthreads();
}
__device__ __forceinline__ void attn_phase(const Ptrs& P, LAS unsigned char* L, int vcu, int G, int wave, int lane) {
    const float lam = lam_value(P);
    for (int u = vcu; u < NB * NH * 16; u += G) attn_unit(P, L, u >> 6, (u >> 4) & 3, u & 15, lam, wave, lane);
}
}
namespace tk {
constexpr int KEYS_LDS = 0, IDX_LDS = 65536;
__device__ __forceinline__ unsigned umax(unsigned a, unsigned b) { return a > b ? a : b; }
__device__ __forceinline__ unsigned umin(unsigned a, unsigned b) { return a < b ? a : b; }
__device__ __forceinline__ unsigned f2sort(float f) { const unsigned u = __float_as_uint(f); return u ^ ((unsigned)((int)u >> 31) | 0x80000000u); }
__device__ __forceinline__ float sort2f(unsigned s) { const unsigned u = (s & 0x80000000u) ? (s ^ 0x80000000u) : ~s; return __uint_as_float(u); }
__device__ __forceinline__ unsigned partner32(unsigned v, int hi) { auto rr = __builtin_amdgcn_permlane32_swap(v, v, false, false); return hi ? rr[0] : rr[1]; }
__device__ __forceinline__ void sort16_desc(unsigned* x) {
#pragma unroll
    for (int k = 2; k <= 16; k <<= 1)
#pragma unroll
        for (int j = k >> 1; j > 0; j >>= 1)
#pragma unroll
            for (int i = 0; i < 16; ++i) { const int l = i ^ j; if (l > i) { const bool desc = ((i & k) == 0); const unsigned mx = umax(x[i], x[l]), mn = umin(x[i], x[l]); x[i] = desc ? mx : mn; x[l] = desc ? mn : mx; } }
}
__device__ __forceinline__ void merge16_desc(unsigned* a, const unsigned* b) {
#pragma unroll
    for (int i = 0; i < 16; ++i) a[i] = umax(a[i], b[15 - i]);
#pragma unroll
    for (int j = 8; j > 0; j >>= 1)
#pragma unroll
        for (int i = 0; i < 16; ++i) { const int l = i ^ j; if (l > i) { const unsigned mx = umax(a[i], a[l]), mn = umin(a[i], a[l]); a[i] = mx; a[l] = mn; } }
}
__device__ __forceinline__ void merge_partner(unsigned* a, int hi) {
    unsigned b[16];
#pragma unroll
    for (int i = 0; i < 16; ++i) b[i] = partner32(a[i], hi);
    merge16_desc(a, b);
}
__device__ __forceinline__ void topk_unit(const Ptrs& P, LAS unsigned char* L, int tb, int hd, int wave, int lane, int tid) {
    const int r32 = lane & 31, hi = lane >> 5;
    const int tok = tb * 256 + wave * 32 + r32;
    const bf16* QPr = (const bf16*)(P.ws + WS_QP) + (size_t)tok * QPW + hd * 256 + hi * 8;
    unsigned S[2][16];
#pragma unroll
    for (int p = 0; p < 2; ++p) {
        bf16x8 qf[8];
#pragma unroll
        for (int d0 = 0; d0 < 8; ++d0) qf[d0] = *(const bf16x8*)(QPr + p * 128 + d0 * 16);
        unsigned x[64];
#pragma unroll
        for (int kb = 0; kb < 4; ++kb) {
            f32x16 acc = f32x16{};
            const LAS unsigned char* ka = L + KEYS_LDS + p * 32768 + hi * 2048 + (kb * 32 + r32) * 16;
#pragma unroll
            for (int d0 = 0; d0 < 8; ++d0) acc = __builtin_amdgcn_mfma_f32_32x32x16_bf16(*(const LAS bf16x8*)(ka + d0 * 4096), qf[d0], acc, 0, 0, 0);
#pragma unroll
            for (int r = 0; r < 16; ++r) x[kb * 16 + r] = (f2sort(acc[r]) & ~127u) | (unsigned)(kb * 32 + (r & 3) + 8 * (r >> 2) + 4 * hi);
        }
        sort16_desc(x); sort16_desc(x + 16); sort16_desc(x + 32); sort16_desc(x + 48);
        merge16_desc(x, x + 16); merge16_desc(x + 32, x + 48); merge16_desc(x, x + 32);
        merge_partner(x, hi);
#pragma unroll
        for (int i = 0; i < 16; ++i) S[p][i] = x[i];
    }
    LAS unsigned char* ib = L + IDX_LDS + tid * 32;
#pragma unroll
    for (int p = 0; p < 2; ++p) {
        u32x4 w;
        w.x = (S[p][0] & 127u) | ((S[p][1] & 127u) << 8) | ((S[p][2] & 127u) << 16) | ((S[p][3] & 127u) << 24);
        w.y = (S[p][4] & 127u) | ((S[p][5] & 127u) << 8) | ((S[p][6] & 127u) << 16) | ((S[p][7] & 127u) << 24);
        w.z = (S[p][8] & 127u) | ((S[p][9] & 127u) << 8) | ((S[p][10] & 127u) << 16) | ((S[p][11] & 127u) << 24);
        w.w = (S[p][12] & 127u) | ((S[p][13] & 127u) << 8) | ((S[p][14] & 127u) << 16) | ((S[p][15] & 127u) << 24);
        *(LAS u32x4*)(ib + p * 16) = w;
    }
    float va[16], vb[16];
#pragma unroll
    for (int i = 0; i < 16; ++i) { const float v0 = sort2f(S[0][i] & ~127u), v1 = sort2f(S[1][i] & ~127u); va[i] = hi ? v1 : v0; vb[i] = hi ? v0 : v1; }
    unsigned c[32];
    { int n = 0;
#pragma unroll
      for (int i = 0; i < 16; ++i)
#pragma unroll
          for (int j = i; j < 16; ++j) if ((i + 1) * (j + 1) <= 16) {
              const unsigned code = hi ? (unsigned)(j * 16 + i) : (unsigned)(i * 16 + j);
              unsigned v = (f2sort(va[i] + vb[j]) & ~255u) | code;
              if (i == j) v = hi ? 0u : v;
              c[n] = v; ++n; }
#pragma unroll
      for (; n < 32; ++n) c[n] = 0u; }
    sort16_desc(c); sort16_desc(c + 16); merge16_desc(c, c + 16);
    merge_partner(c, hi);
    const float tmax = sort2f(c[0] & ~255u); const unsigned hmask = (unsigned)(-hi);
    float e[8]; unsigned cd[8]; float es = 0.f;
#pragma unroll
    for (int k = 0; k < 8; ++k) { const unsigned v = (c[k + 8] & hmask) | (c[k] & ~hmask); cd[k] = v & 255u; e[k] = __expf(sort2f(v & ~255u) - tmax); es += e[k]; }
    const float rs = 1.f / att::halves_sum(es);
    asm volatile("s_waitcnt lgkmcnt(0)" ::: "memory");
    unsigned o[8];
#pragma unroll
    for (int k = 0; k < 8; ++k) { const unsigned i1 = ib[cd[k] >> 4], i2 = ib[16 + (cd[k] & 15u)]; o[k] = ((i1 * 128u + i2) << 16) | f2h(e[k] * rs); }
    unsigned* SEL = (unsigned*)(P.ws + WS_SEL) + (size_t)tok * 128 + hd * 16 + hi * 8;
    *(u32x4*)SEL = (u32x4){o[0], o[1], o[2], o[3]}; *(u32x4*)(SEL + 4) = (u32x4){o[4], o[5], o[6], o[7]};
}
__device__ __forceinline__ void topk_phase(const Ptrs& P, LAS unsigned char* L, int vcu, int G, int wave, int lane, int tid) {
    const int hd = vcu & 7;
    { const int key = tid & 127, p = (tid >> 7) & 1, cg = tid >> 8;
      const bf16* src = (const bf16*)(P.ws + WS_KEYS) + ((size_t)(hd * 2 + p) * NKEY + key) * PHD + cg * 64;
      u32x4 v[8];
#pragma unroll
      for (int i = 0; i < 8; ++i) v[i] = *(const u32x4*)(src + i * 8);
#pragma unroll
      for (int i = 0; i < 8; ++i) *(LAS u32x4*)(L + KEYS_LDS + p * 32768 + (cg * 8 + i) * 2048 + key * 16) = v[i]; }
    asm volatile("s_waitcnt lgkmcnt(0)" ::: "memory"); __syncthreads();
    for (int tb = vcu >> 3; tb < NTOK / 256; tb += (G >> 3)) topk_unit(P, L, tb, hd, wave, lane, tid);
    asm volatile("s_waitcnt lgkmcnt(0)" ::: "memory"); __syncthreads();
}
}
namespace pe {
typedef __bf16 bf16x2_t __attribute__((ext_vector_type(2)));
__device__ __forceinline__ float dot2(unsigned a, unsigned b, float c) { return __builtin_amdgcn_fdot2_f32_bf16(__builtin_bit_cast(bf16x2_t, a), __builtin_bit_cast(bf16x2_t, b), c, false); }
__device__ __forceinline__ float dot8(const u32x4& a, const u32x4& b, float c) { c = dot2(a.x, b.x, c); c = dot2(a.y, b.y, c); c = dot2(a.z, b.z, c); return dot2(a.w, b.w, c); }
__device__ __forceinline__ void axpy8(float w, const u32x4& v, float* o) {
    o[0] += w * bflo(v.x); o[1] += w * bfhi(v.x); o[2] += w * bflo(v.y); o[3] += w * bfhi(v.y);
    o[4] += w * bflo(v.z); o[5] += w * bfhi(v.z); o[6] += w * bflo(v.w); o[7] += w * bfhi(v.w);
}
__device__ __forceinline__ void peer_token(const Ptrs& P, int tok, int lane) {
    const unsigned char* EU = P.ws + WS_EU; const unsigned char* EV = P.ws + WS_EV;
    const unsigned* SEL = (const unsigned*)(P.ws + WS_SEL) + (size_t)tok * 128;
    const unsigned e0 = SEL[lane], e1 = SEL[64 + lane];
    const unsigned char* hrow = P.ws + WS_HN + (size_t)tok * (DM * 2) + lane * 16;
    const u32x4 hA = *(const u32x4*)hrow, hB = *(const u32x4*)(hrow + 1024);
    float out[16];
#pragma unroll
    for (int i = 0; i < 16; ++i) out[i] = 0.f;
    float part[16];
    float wcur = 0.f;
    const int loff = lane * 16;
#define PE_U_GROUP(bt, g) do { u32x4 ua_[4], ub_[4]; \
        _Pragma("unroll") for (int q_ = 0; q_ < 4; ++q_) { const int k_ = (bt) * 16 + (g) * 4 + q_; const unsigned es_ = __builtin_amdgcn_readlane((k_ < 64) ? e0 : e1, k_ & 63); \
            const unsigned char* r_ = EU + (size_t)(es_ >> 16) * (DM * 2) + loff; ua_[q_] = *(const u32x4*)r_; ub_[q_] = *(const u32x4*)(r_ + 1024); } \
        _Pragma("unroll") for (int q_ = 0; q_ < 4; ++q_) part[(g) * 4 + q_] = dot8(ub_[q_], hB, dot8(ua_[q_], hA, 0.f)); } while (0)
#define PE_REDUCE(bt) do { float v8_[8], v4_[4], v2_[2]; \
        { const bool b_ = lane & 1; _Pragma("unroll") for (int i_ = 0; i_ < 8; ++i_) { const float keep_ = b_ ? part[2 * i_ + 1] : part[2 * i_], send_ = b_ ? part[2 * i_] : part[2 * i_ + 1]; v8_[i_] = keep_ + __shfl_xor(send_, 1); } } \
        { const bool b_ = lane & 2; _Pragma("unroll") for (int i_ = 0; i_ < 4; ++i_) { const float keep_ = b_ ? v8_[2 * i_ + 1] : v8_[2 * i_], send_ = b_ ? v8_[2 * i_] : v8_[2 * i_ + 1]; v4_[i_] = keep_ + __shfl_xor(send_, 2); } } \
        { const bool b_ = lane & 4; _Pragma("unroll") for (int i_ = 0; i_ < 2; ++i_) { const float keep_ = b_ ? v4_[2 * i_ + 1] : v4_[2 * i_], send_ = b_ ? v4_[2 * i_] : v4_[2 * i_ + 1]; v2_[i_] = keep_ + __shfl_xor(send_, 4); } } \
        float a_; { const bool b_ = lane & 8; const float keep_ = b_ ? v2_[1] : v2_[0], send_ = b_ ? v2_[0] : v2_[1]; a_ = keep_ + __shfl_xor(send_, 8); } \
        a_ += __shfl_xor(a_, 16); a_ += __shfl_xor(a_, 32); \
        const unsigned eg_ = __shfl(((bt) < 4) ? e0 : e1, ((bt) & 3) * 16 + (lane & 15)); \
        wcur = h2f(eg_) * (0.5f * a_ * (1.f + erff(a_ * 0.70710678118654752f))); } while (0)
    PE_U_GROUP(0, 0); PE_U_GROUP(0, 1); PE_U_GROUP(0, 2); PE_U_GROUP(0, 3);
    for (int bt = 0; bt < 8; ++bt) {
        float w; PE_REDUCE(bt); w = wcur;
#pragma unroll
        for (int g = 0; g < 4; ++g) {
            u32x4 va[4], vb[4];
#pragma unroll
            for (int q = 0; q < 4; ++q) { const int k = bt * 16 + g * 4 + q; const unsigned es = __builtin_amdgcn_readlane((k < 64) ? e0 : e1, k & 63);
                const unsigned char* r = EV + (size_t)(es >> 16) * (DM * 2) + loff; va[q] = *(const u32x4*)r; vb[q] = *(const u32x4*)(r + 1024); }
            if (bt < 7) PE_U_GROUP(bt + 1, g);
#pragma unroll
            for (int q = 0; q < 4; ++q) { const float wk = __builtin_bit_cast(float, __builtin_amdgcn_readlane(__builtin_bit_cast(unsigned, w), g * 4 + q)); axpy8(wk, va[q], out); axpy8(wk, vb[q], out + 8); }
        }
    }
#undef PE_U_GROUP
#undef PE_REDUCE
    const float* hr = (const float*)(P.ws + WS_H) + (size_t)tok * DM + lane * 8;
    f32x4 y[4];
    y[0] = *(const f32x4*)hr; y[1] = *(const f32x4*)(hr + 4); y[2] = *(const f32x4*)(hr + 512); y[3] = *(const f32x4*)(hr + 516);
    float ss = 0.f;
#pragma unroll
    for (int i = 0; i < 4; ++i) { y[i] += (f32x4){out[4 * i], out[4 * i + 1], out[4 * i + 2], out[4 * i + 3]}; ss += (y[i].x * y[i].x + y[i].y * y[i].y) + (y[i].z * y[i].z + y[i].w * y[i].w); }
    const float rstd = rsqrtf(wave_sum(ss) * (1.f / DM) + EPS);
    const float* fw = P.final_norm_w + lane * 8;
    float* orow = P.out + (size_t)tok * DM + lane * 8;
    *(f32x4*)orow = y[0] * rstd * *(const f32x4*)fw; *(f32x4*)(orow + 4) = y[1] * rstd * *(const f32x4*)(fw + 4);
    *(f32x4*)(orow + 512) = y[2] * rstd * *(const f32x4*)(fw + 512); *(f32x4*)(orow + 516) = y[3] * rstd * *(const f32x4*)(fw + 516);
}
__device__ __forceinline__ void peer_phase(const Ptrs& P, int gw, int NGW, int lane) {
    for (int tok = gw; tok < NTOK; tok += NGW) peer_token(P, tok, lane);
}
}

struct Args { Ptrs P; int ph_lo, ph_hi, bar_region, pad; };
constexpr int N_PHASES = 9;

__global__ void __launch_bounds__(NWAVES * 64, 2) mk_fwd(Args args) {
    extern __shared__ __attribute__((aligned(16))) unsigned char lds[];
    LAS unsigned char* L = (LAS unsigned char*)lds;
    volatile LAS unsigned* MISC = (volatile LAS unsigned*)(L + MISC_OFF);
    const Ptrs& P = args.P;
    const int tid = threadIdx.x, lane = tid & 63, wave = __builtin_amdgcn_readfirstlane(tid >> 6);
    const int G = gridDim.x, bx = blockIdx.x, vcu = (G % 8 == 0) ? (bx % 8) * (G / 8) + bx / 8 : bx;
    const int gw = vcu * NWAVES + wave, NGW = G * NWAVES;
    unsigned char* ws = P.ws;
    unsigned* ctl = (unsigned*)(ws + WS_CTL);
    for (int u = tid; u < (LDS_BYTES - LDSCTL_OFF) / 4; u += NWAVES * 64) ((LAS unsigned*)(L + LDSCTL_OFF))[u] = 0u;
    __syncthreads();
    const int lo = args.ph_lo, hi = args.ph_hi;
    const bool multi = (hi - lo) > 1;
    unsigned* barw = ctl + CW_BAR + args.bar_region * XCD_BAR_WORDS;
    XcdBarrier bar; bar.bar = barw; bar.x = 0; bar.st = nullptr;
    if (multi) bar = xcd_barrier_post(barw, MISC + 8);
#define IN(k) (lo <= (k) && (k) < hi)
#define SEAM(k) do { if (IN(k) && IN((k) + 1)) xcd_barrier(bar); } while (0)

    if (IN(0)) { p0_prologue(P, gw, NGW, lane, (LAS float*)L + wave * (64 * 33)); SEAM(0); }
    if (IN(1)) {
        pg8::Gemm g{(const bf16*)(ws + WS_XN), (const bf16*)(ws + WS_WIN), NTOK, INW, DM}; pg8::StaticOrder S; S.init(NTOK, INW, G, bx);
        pg8::EpiInProj E{ws, (bf16*)P.out, (const float*)(ws + WS_ROPE), (const float*)(ws + WS_ROPE) + SEQ * 32};
        pg8::gemm_phase<pg8::EpiInProj, pg8::StaticOrder, true, true>(L, g, S, E);
        SEAM(1);
    }
    if (IN(2)) { conv_rows(P, gw, NGW, lane); att::attn_phase(P, L, vcu, G, wave, lane); SEAM(2); }
    if (IN(3)) {
        { pg8::Gemm g{(const bf16*)(ws + WS_ATTN), (const bf16*)(ws + WS_WPA), NTOK, DM, AW}; pg8::StaticOrder S; S.init(NTOK, DM, G, bx);
          pg8::EpiGate<0> E{(const bf16*)P.out, nullptr, (bf16*)(ws + WS_TMP)};
          pg8::gemm_phase<pg8::EpiGate<0>, pg8::StaticOrder, true, true>(L, g, S, E); }
        asm volatile("s_waitcnt vmcnt(0)" ::: "memory"); __syncthreads();
        { pg8::Gemm g{(const bf16*)(ws + WS_CF), (const bf16*)(ws + WS_WPB), NTOK, DM, CW}; pg8::StaticOrder S; S.init(NTOK, DM, G, bx);
          pg8::EpiGate<1> E{(const bf16*)P.out + (size_t)NTOK * DM, (const bf16*)(ws + WS_TMP), (bf16*)(ws + WS_MG)};
          pg8::gemm_phase<pg8::EpiGate<1>, pg8::StaticOrder, true, true>(L, g, S, E); }
        SEAM(3);
    }
    if (IN(4)) {
        pg8::Gemm g{(const bf16*)(ws + WS_MG), (const bf16*)(ws + WS_WO), NTOK, DM, DM}; pg8::StaticOrder S; S.init(NTOK, DM, G, bx);
        pg8::EpiResid E{P.x, (float*)(ws + WS_H)};
        pg8::gemm_phase<pg8::EpiResid, pg8::StaticOrder, true, true>(L, g, S, E);
        SEAM(4);
    }
    if (IN(5)) { p5_hn(P, gw, NGW, lane); SEAM(5); }
    if (IN(6)) {
        pg8::Gemm g{(const bf16*)(ws + WS_HN), (const bf16*)(ws + WS_WQ), NTOK, QPW, DM}; pg8::StaticOrder S; S.init(NTOK, QPW, G, bx);
        pg8::EpiPlainBf16 E{(bf16*)(ws + WS_QP), QPW};
        pg8::gemm_phase<pg8::EpiPlainBf16, pg8::StaticOrder, true, true>(L, g, S, E);
        SEAM(6);
    }
    if (IN(7)) { tk::topk_phase(P, L, vcu, G, wave, lane, tid); SEAM(7); }
    if (IN(8)) { pe::peer_phase(P, gw, NGW, lane); }
#undef IN
#undef SEAM
}
static int g_grid = 0;
static void mk_launch(const Ptrs& P, int lo, int hi, int region, hipStream_t stream) {
    Args a{}; a.P = P; a.ph_lo = lo; a.ph_hi = hi; a.bar_region = region;
    void* params[] = {&a};
    hipError_t e = hipLaunchCooperativeKernel((const void*)mk_fwd, dim3(g_grid), dim3(NWAVES * 64), params, LDS_BYTES, stream);
    if (e != hipSuccess) fprintf(stderr, "mk launch failed: %s\n", hipGetErrorString(e));
}
extern "C" void kernel_launch(void* const* d_in, const int* in_sizes, int n_in, void* d_out, int out_size, void* d_ws, size_t ws_size, hipStream_t stream) {
    Ptrs P{};
    const float** pp = (const float**)&P;
    for (int i = 0; i < 18; ++i) pp[i] = (const float*)d_in[i];
    P.out = (float*)d_out; P.ws = (unsigned char*)d_ws;
    if (g_grid == 0) {
        (void)hipFuncSetAttribute((const void*)nk_prep, hipFuncAttributeMaxDynamicSharedMemorySize, 8 * 64 * 33 * 4);
        (void)hipFuncSetAttribute((const void*)nk_topk, hipFuncAttributeMaxDynamicSharedMemorySize, 64 * 320 * 4);
        (void)hipFuncSetAttribute((const void*)mk_fwd, hipFuncAttributeMaxDynamicSharedMemorySize, LDS_BYTES);
        int dev = 0, cus = 0, per_cu = 0;
        (void)hipGetDevice(&dev); (void)hipDeviceGetAttribute(&cus, hipDeviceAttributeMultiprocessorCount, dev);
        (void)hipOccupancyMaxActiveBlocksPerMultiprocessor(&per_cu, (const void*)mk_fwd, NWAVES * 64, LDS_BYTES);
        if (per_cu < 1) { fprintf(stderr, "occupancy query says %d blocks/CU\n", per_cu); per_cu = 1; }
        g_grid = cus * 1;
    }
    (void)hipMemsetAsync((char*)d_ws + WS_CTL, 0, CTL_BYTES, stream);
    mk_launch(P, 0, 9, 0, stream);
}
```

```cpp
#include <hip/hip_runtime.h>
#include <cstdint>
#include <cstdio>

constexpr int NB = 4, SEQ = 4096, DM = 1024, NTOK = NB * SEQ;
constexpr int NH = 4, DH = 64, DV = 128, QKW = 512, AW = 512, CW = 512;
constexpr int INW = 5120;
constexpr int PH = 8, NKEY = 128, PHD = 128, TOPK = 16, NEXP = 16384, QPW = 2048;
constexpr float EPS = 1e-6f;
constexpr float LAMBDA_INIT = 0.2f;
constexpr float C2 = 0.125f * 1.4426950408889634f;

constexpr size_t MiB = 1u << 20;
constexpr size_t WS_CTL = 0, CTL_BYTES = 1 * MiB;
constexpr size_t WS_WIN = 1 * MiB;
constexpr size_t WS_WPA = 11 * MiB;
constexpr size_t WS_WPB = 12 * MiB;
constexpr size_t WS_WO = 13 * MiB;
constexpr size_t WS_WQ = 15 * MiB;
constexpr size_t WS_KEYS = 19 * MiB;
constexpr size_t WS_ROPE = 20 * MiB;
constexpr size_t WS_EU = 21 * MiB;
constexpr size_t WS_EV = 37 * MiB;
constexpr size_t WS_SCU = 53 * MiB;
constexpr size_t WS_XN = 85 * MiB;
constexpr size_t WS_ATTN = 85 * MiB;
constexpr size_t WS_CF = 101 * MiB;
constexpr size_t WS_HN = 85 * MiB;
constexpr size_t WS_Q = 117 * MiB;
constexpr size_t WS_KV = 133 * MiB;
constexpr size_t WS_BG = 165 * MiB, WS_CG = 181 * MiB, WS_XC = 197 * MiB;
constexpr size_t WS_MG = 117 * MiB;
constexpr size_t WS_TMP = 149 * MiB;
constexpr size_t WS_H = 181 * MiB;
constexpr size_t WS_QP = 117 * MiB;
constexpr size_t WS_SEL = 245 * MiB;
constexpr size_t WS_END = 256 * MiB;

typedef unsigned short bf16;
typedef float f32x4 __attribute__((ext_vector_type(4)));
typedef float f32x16 __attribute__((ext_vector_type(16)));
typedef float f32x2 __attribute__((ext_vector_type(2)));
typedef unsigned u32x4 __attribute__((ext_vector_type(4)));
typedef unsigned u32x2 __attribute__((ext_vector_type(2)));
typedef short bf16x8 __attribute__((ext_vector_type(8)));
#define LAS __attribute__((address_space(3)))

__host__ __device__ __forceinline__ unsigned f2bf(float f) { unsigned u = __builtin_bit_cast(unsigned, f); return (u + 0x7fffu + ((u >> 16) & 1u)) >> 16; }
__host__ __device__ __forceinline__ unsigned pk2(float lo, float hi) { return f2bf(lo) | (f2bf(hi) << 16); }
__host__ __device__ __forceinline__ float bf2f(unsigned h) { return __builtin_bit_cast(float, (h & 0xffffu) << 16); }
__device__ __forceinline__ float bflo(unsigned w) { return __builtin_bit_cast(float, w << 16); }
__device__ __forceinline__ float bfhi(unsigned w) { return __builtin_bit_cast(float, w & 0xffff0000u); }

__host__ __device__ __forceinline__ size_t kv_tile_off(int b, int h, int tile) { return (size_t)((b * NH + h) * 64 + tile) * 32768; }
__host__ __device__ __forceinline__ int k_img_off(int m, int kvr, int p) { return m * 8192 + (p >> 3) * 1024 + kvr * 16 + (p & 7) * 2; }
__host__ __device__ __forceinline__ int v_img_off(int kvr, int e) { return 16384 + (e >> 5) * 4096 + (kvr >> 4) * 1024 + (kvr & 15) * 64 + (e & 31) * 2; }
struct Ptrs {
    const float *x, *attn_norm_w, *w_in, *lq1, *lk1, *lq2, *lk2, *subln_w, *conv_w, *w_pa, *w_pb, *w_o, *ffn_norm_w, *w_query, *sub_keys, *expert_u, *expert_v, *final_norm_w;
    float* out; unsigned char* ws;
};
__device__ __forceinline__ float wave_sum(float v) {
#pragma unroll
    for (int o = 1; o < 64; o <<= 1) v += __shfl_xor(v, o);
    return v;
}
__device__ __forceinline__ int rope_row(int c) { if (c < 1024) { const int g = c >> 6, d = c & 63; return (g << 6) + 2 * (d & 31) + (d >> 5); } return c; }
template <int MAP>
__device__ __forceinline__ void p0_transpose_item(const float* W, int K, int N, bf16* WT, LAS float* scr, int item, int lane) {
    const int nblk = N / 32, kb = item / nblk, nb = item % nblk, k0 = 64 * kb, n0 = 32 * nb;
#pragma unroll 8
    for (int i = 0; i < 32; ++i) { const int kk = 2 * i + (lane >> 5); scr[kk * 33 + (lane & 31)] = W[(size_t)(k0 + kk) * N + n0 + (lane & 31)]; }
    asm volatile("s_waitcnt lgkmcnt(0)" ::: "memory");
    const int c = lane & 7;
#pragma unroll
    for (int j = 0; j < 4; ++j) { const int n = (lane >> 3) + 8 * j; const LAS float* s = scr + (8 * c) * 33 + n;
        u32x4 o; o.x = pk2(s[0 * 33], s[1 * 33]); o.y = pk2(s[2 * 33], s[3 * 33]); o.z = pk2(s[4 * 33], s[5 * 33]); o.w = pk2(s[6 * 33], s[7 * 33]);
        const int drow = MAP ? rope_row(n0 + n) : (n0 + n);
        *(u32x4*)(WT + (size_t)drow * K + k0 + 8 * c) = o; }
    asm volatile("s_waitcnt lgkmcnt(0)" ::: "memory");
}
__device__ __forceinline__ void p0_cvt_chunk(const float* src, bf16* dst, int lane) {
    const f32x4 a = *(const f32x4*)(src + lane * 8), b = *(const f32x4*)(src + lane * 8 + 4);
    u32x4 o; o.x = pk2(a.x, a.y); o.y = pk2(a.z, a.w); o.z = pk2(b.x, b.y); o.w = pk2(b.z, b.w);
    *(u32x4*)(dst + lane * 8) = o;
}
__device__ __forceinline__ void rms_row_to_bf16(const float* xrow, const float* w, bf16* orow, int lane) {
    const f32x4* xr = (const f32x4*)xrow + lane; const f32x4* wr = (const f32x4*)w + lane;
    f32x4 v[4]; float s = 0.f;
#pragma unroll
    for (int j = 0; j < 4; ++j) { v[j] = xr[64 * j]; s += (v[j].x * v[j].x + v[j].y * v[j].y) + (v[j].z * v[j].z + v[j].w * v[j].w); }
    const float rstd = rsqrtf(wave_sum(s) * (1.f / DM) + EPS);
    unsigned long long* o8 = (unsigned long long*)orow + lane;
#pragma unroll
    for (int j = 0; j < 4; ++j) { const f32x4 ww = wr[64 * j];
        o8[64 * j] = (unsigned long long)pk2(v[j].x * rstd * ww.x, v[j].y * rstd * ww.y) | ((unsigned long long)pk2(v[j].z * rstd * ww.z, v[j].w * rstd * ww.w) << 32); }
}
__device__ __forceinline__ void p0_prologue(const Ptrs& P, int gw, int NGW, int lane, LAS float* scr) {
    unsigned char* ws = P.ws;
    bf16* WIN = (bf16*)(ws + WS_WIN); bf16* WPA = (bf16*)(ws + WS_WPA); bf16* WPB = (bf16*)(ws + WS_WPB); bf16* WO = (bf16*)(ws + WS_WO); bf16* WQ = (bf16*)(ws + WS_WQ);
    constexpr int I_IN = (DM / 64) * (INW / 32), I_PA = (AW / 64) * (DM / 32), I_PB = (CW / 64) * (DM / 32), I_O = (DM / 64) * (DM / 32), I_Q = (DM / 64) * (QPW / 32);
    constexpr int NITEMS = I_IN + I_PA + I_PB + I_O + I_Q;
    for (int it = gw; it < NITEMS; it += NGW) {
        int r = it;
        if (r < I_IN) { p0_transpose_item<1>(P.w_in, DM, INW, WIN, scr, r, lane); continue; } r -= I_IN;
        if (r < I_PA) { p0_transpose_item<0>(P.w_pa, AW, DM, WPA, scr, r, lane); continue; } r -= I_PA;
        if (r < I_PB) { p0_transpose_item<0>(P.w_pb, CW, DM, WPB, scr, r, lane); continue; } r -= I_PB;
        if (r < I_O) { p0_transpose_item<0>(P.w_o, DM, DM, WO, scr, r, lane); continue; } r -= I_O;
        p0_transpose_item<0>(P.w_query, DM, QPW, WQ, scr, r, lane);
    }
    constexpr int C_K = (PH * 2 * NKEY * PHD) / 512;
    for (int it = gw; it < C_K; it += NGW) p0_cvt_chunk(P.sub_keys + (size_t)it * 512, (bf16*)(ws + WS_KEYS) + (size_t)it * 512, lane);
    for (int it = gw; it < 2 * NEXP; it += NGW) {
        const int which = it >= NEXP, e = it - which * NEXP;
        const float* src = (which ? P.expert_v : P.expert_u) + (size_t)e * DM + lane * 16;
        f32x4 v[4]; float am = 0.f;
#pragma unroll
        for (int j = 0; j < 4; ++j) { v[j] = *(const f32x4*)(src + 4 * j); am = fmaxf(am, fmaxf(fmaxf(fabsf(v[j].x), fabsf(v[j].y)), fmaxf(fabsf(v[j].z), fabsf(v[j].w)))); }
#pragma unroll
        for (int o = 1; o < 64; o <<= 1) am = fmaxf(am, __shfl_xor(am, o));
        const float sc = am > 0.f ? 240.f / am : 1.f;
        u32x4 w;
#pragma unroll
        for (int j = 0; j < 4; ++j) { int t = 0; t = __builtin_amdgcn_cvt_pk_fp8_f32(v[j].x * sc, v[j].y * sc, t, false); t = __builtin_amdgcn_cvt_pk_fp8_f32(v[j].z * sc, v[j].w * sc, t, true); w[j] = (unsigned)t; }
        *(u32x4*)(ws + (which ? WS_EV : WS_EU) + (size_t)e * DM + lane * 16) = w;
        if (lane == 0) ((float*)(ws + WS_SCU))[which * NEXP + e] = 1.f / sc;
    }
    for (int m = gw; m < NTOK; m += NGW) rms_row_to_bf16(P.x + (size_t)m * DM, P.attn_norm_w, (bf16*)(ws + WS_XN) + (size_t)m * DM, lane);
    float* COS = (float*)(ws + WS_ROPE); float* SIN = COS + SEQ * 32;
    for (int e = gw * 64 + lane; e < SEQ * 32; e += NGW * 64) {
        const int pos = e >> 5, i = e & 31;
        const double inv = exp(-(double)i * (9.210340371976184 / 32.0));
        double s, c; sincos((double)pos * inv, &s, &c);
        COS[e] = (float)c; SIN[e] = (float)s;
    }
}
__device__ __forceinline__ void p5_hn(const Ptrs& P, int gw, int NGW, int lane) {
    for (int m = gw; m < NTOK; m += NGW) rms_row_to_bf16((const float*)(P.ws + WS_H) + (size_t)m * DM, P.ffn_norm_w, (bf16*)(P.ws + WS_HN) + (size_t)m * DM, lane);
}
__device__ __forceinline__ float lam_value(const Ptrs& P) {
    float a = 0.f, b = 0.f;
    for (int i = 0; i < DH; ++i) { a += P.lq1[i] * P.lk1[i]; b += P.lq2[i] * P.lk2[i]; }
    return expf(a) - expf(b) + LAMBDA_INIT;
}
__device__ __forceinline__ float sigmoidf_(float v) { return 1.f / (1.f + expf(-v)); }

__global__ void __launch_bounds__(512) nk_prep(Ptrs P) {
    extern __shared__ __attribute__((aligned(16))) unsigned char lds[];
    const int lane = threadIdx.x & 63, wave = threadIdx.x >> 6;
    p0_prologue(P, blockIdx.x * 8 + wave, gridDim.x * 8, lane, (LAS float*)lds + wave * (64 * 33));
}
__global__ void __launch_bounds__(256) nk_inproj(Ptrs P) {
    __shared__ float xr[4][DM];
    const int t0 = blockIdx.x * 4, tid = threadIdx.x;
    const bf16* XN = (const bf16*)(P.ws + WS_XN);
    for (int i = tid; i < 4 * DM; i += 256) xr[i >> 10][i & 1023] = bf2f(XN[(size_t)t0 * DM + i]);
    __syncthreads();
    const float* COS = (const float*)(P.ws + WS_ROPE); const float* SIN = COS + SEQ * 32;
    bf16* Q = (bf16*)(P.ws + WS_Q); unsigned char* KV = P.ws + WS_KV;
    bf16* SG = (bf16*)P.out;
    for (int j = tid; j < 4608; j += 256) {
        int c1, c2 = -1;
        if (j < 512) { c1 = (j >> 5) * 64 + (j & 31); c2 = c1 + 32; }
        else if (j < 1024) c1 = 1024 + (j - 512);
        else if (j < 2560) c1 = 1536 + (j - 1024);
        else c1 = 3072 + (j - 2560);
        float a0 = 0.f, a1 = 0.f, a2 = 0.f, a3 = 0.f, b0 = 0.f, b1 = 0.f, b2 = 0.f, b3 = 0.f;
        for (int k = 0; k < DM; ++k) {
            const float w1 = P.w_in[(size_t)k * INW + c1];
            a0 += xr[0][k] * w1; a1 += xr[1][k] * w1; a2 += xr[2][k] * w1; a3 += xr[3][k] * w1;
            if (c2 >= 0) { const float w2 = P.w_in[(size_t)k * INW + c2]; b0 += xr[0][k] * w2; b1 += xr[1][k] * w2; b2 += xr[2][k] * w2; b3 += xr[3][k] * w2; }
        }
#pragma unroll
        for (int r = 0; r < 4; ++r) {
            const float a = r == 0 ? a0 : r == 1 ? a1 : r == 2 ? a2 : a3, b = r == 0 ? b0 : r == 1 ? b1 : r == 2 ? b2 : b3;
            const int t = t0 + r, bb = t >> 12, pos = t & 4095, tile = pos >> 6, kvr = pos & 63;
            if (j < 512) {
                const int g = j >> 5, i = j & 31; const float cs = COS[pos * 32 + i], sn = SIN[pos * 32 + i];
                const float o1 = a * cs - b * sn, o2 = b * cs + a * sn;
                if (g < 8) { Q[(size_t)t * QKW + g * 64 + 2 * i] = (bf16)f2bf(o1 * C2); Q[(size_t)t * QKW + g * 64 + 2 * i + 1] = (bf16)f2bf(o2 * C2); }
                else { const int gk = g - 8, h = gk >> 1, m = gk & 1; unsigned char* tb = KV + kv_tile_off(bb, h, tile);
                    *(bf16*)(tb + k_img_off(m, kvr, 2 * i)) = (bf16)f2bf(o1); *(bf16*)(tb + k_img_off(m, kvr, 2 * i + 1)) = (bf16)f2bf(o2); }
            } else if (j < 1024) { const int ee = j - 512, h = ee >> 7, e = ee & 127; *(bf16*)(KV + kv_tile_off(bb, h, tile) + v_img_off(kvr, e)) = (bf16)f2bf(a); }
            else if (j < 2560) { const int jj = j - 1024, which = jj >> 9, cc = jj & 511; bf16* dst = (bf16*)(P.ws + (which == 0 ? WS_BG : which == 1 ? WS_CG : WS_XC)); dst[(size_t)t * CW + cc] = (bf16)f2bf(a); }
            else { const int jj = j - 2560, which = jj >> 10, cc = jj & 1023; SG[(size_t)which * NTOK * DM + (size_t)t * DM + cc] = (bf16)f2bf(sigmoidf_(a)); }
        }
    }
}
__device__ __forceinline__ void conv_rows(const Ptrs& P, int gw, int NGW, int lane) {
    const bf16* BG = (const bf16*)(P.ws + WS_BG); const bf16* CG = (const bf16*)(P.ws + WS_CG); const bf16* XC = (const bf16*)(P.ws + WS_XC); bf16* CF = (bf16*)(P.ws + WS_CF);
    for (int t = gw; t < NTOK; t += NGW) {
        const int pos = t & 4095; const size_t o = (size_t)t * CW + lane * 8;
        const u32x4 g = *(const u32x4*)(BG + o), c1 = *(const u32x4*)(CG + o), x1 = *(const u32x4*)(XC + o);
        u32x4 c0 = (u32x4){0, 0, 0, 0}, x0 = c0, c2 = c0, x2 = c0;
        if (pos > 0) { c0 = *(const u32x4*)(CG + o - CW); x0 = *(const u32x4*)(XC + o - CW); }
        if (pos < SEQ - 1) { c2 = *(const u32x4*)(CG + o + CW); x2 = *(const u32x4*)(XC + o + CW); }
        const f32x4 wa0 = *(const f32x4*)(P.conv_w + lane * 8), wa1 = *(const f32x4*)(P.conv_w + lane * 8 + 4);
        const f32x4 wb0 = *(const f32x4*)(P.conv_w + CW + lane * 8), wb1 = *(const f32x4*)(P.conv_w + CW + lane * 8 + 4);
        const f32x4 wc0 = *(const f32x4*)(P.conv_w + 2 * CW + lane * 8), wc1 = *(const f32x4*)(P.conv_w + 2 * CW + lane * 8 + 4);
        float r[8];
#pragma unroll
        for (int q = 0; q < 4; ++q) {
            const float w0l = q < 2 ? wa0[2 * q] : wa1[2 * q - 4], w0h = q < 2 ? wa0[2 * q + 1] : wa1[2 * q - 3];
            const float w1l = q < 2 ? wb0[2 * q] : wb1[2 * q - 4], w1h = q < 2 ? wb0[2 * q + 1] : wb1[2 * q - 3];
            const float w2l = q < 2 ? wc0[2 * q] : wc1[2 * q - 4], w2h = q < 2 ? wc0[2 * q + 1] : wc1[2 * q - 3];
            r[2 * q] = bflo(g[q]) * (w0l * bflo(c0[q]) * bflo(x0[q]) + w1l * bflo(c1[q]) * bflo(x1[q]) + w2l * bflo(c2[q]) * bflo(x2[q]));
            r[2 * q + 1] = bfhi(g[q]) * (w0h * bfhi(c0[q]) * bfhi(x0[q]) + w1h * bfhi(c1[q]) * bfhi(x1[q]) + w2h * bfhi(c2[q]) * bfhi(x2[q]));
        }
        u32x4 ov; ov.x = pk2(r[0], r[1]); ov.y = pk2(r[2], r[3]); ov.z = pk2(r[4], r[5]); ov.w = pk2(r[6], r[7]);
        *(u32x4*)(CF + o) = ov;
    }
}
__global__ void __launch_bounds__(512) nk_conv(Ptrs P) { conv_rows(P, blockIdx.x * 8 + (threadIdx.x >> 6), gridDim.x * 8, threadIdx.x & 63); }
__global__ void __launch_bounds__(256) nk_attn(Ptrs P) {
    const int gid = blockIdx.x * 256 + threadIdx.x;
    const int q = gid & 4095, eq = (gid >> 12) & 3, m = (gid >> 14) & 1, h = (gid >> 15) & 3, b = gid >> 17;
    const bf16* Q = (const bf16*)(P.ws + WS_Q); const unsigned char* KV = P.ws + WS_KV;
    const int t = b * SEQ + q;
    float qv[64];
#pragma unroll
    for (int p = 0; p < 64; ++p) qv[p] = bf2f(Q[(size_t)t * QKW + (h * 2 + m) * 64 + p]);
    float o[32];
#pragma unroll
    for (int e = 0; e < 32; ++e) o[e] = 0.f;
    float mx = -1e30f, l = 0.f;
    for (int kv = 0; kv < SEQ; ++kv) {
        const unsigned char* tb = KV + kv_tile_off(b, h, kv >> 6); const int kvr = kv & 63;
        float s = 0.f;
#pragma unroll
        for (int c = 0; c < 8; ++c) { const u32x4 kk = *(const u32x4*)(tb + k_img_off(m, kvr, c * 8));
#pragma unroll
            for (int w = 0; w < 4; ++w) s += qv[c * 8 + 2 * w] * bflo(kk[w]) + qv[c * 8 + 2 * w + 1] * bfhi(kk[w]); }
        if (s > mx) { const float f = exp2f(mx - s); l *= f;
#pragma unroll
            for (int e = 0; e < 32; ++e) o[e] *= f;
            mx = s; }
        const float p = exp2f(s - mx); l += p;
#pragma unroll
        for (int c = 0; c < 4; ++c) { const u32x4 vv = *(const u32x4*)(tb + v_img_off(kvr, eq * 32 + c * 8));
#pragma unroll
            for (int w = 0; w < 4; ++w) { o[c * 8 + 2 * w] += p * bflo(vv[w]); o[c * 8 + 2 * w + 1] += p * bfhi(vv[w]); } }
    }
    float* TMPF = (float*)(P.ws + WS_H);
    const float rl = 1.f / l;
#pragma unroll
    for (int e = 0; e < 32; ++e) TMPF[((size_t)((b * NH + h) * SEQ + q) * 2 + m) * DV + eq * 32 + e] = o[e] * rl;
}
__global__ void __launch_bounds__(256) nk_attn_fin(Ptrs P) {
    const int gw = blockIdx.x * 4 + (threadIdx.x >> 6), lane = threadIdx.x & 63;
    const int q = gw & 4095, h = (gw >> 12) & 3, b = gw >> 14;
    const float lam = lam_value(P);
    const float* TMPF = (const float*)(P.ws + WS_H) + (size_t)gw * 2 * DV;
    const float d0 = TMPF[lane * 2] - lam * TMPF[DV + lane * 2], d1 = TMPF[lane * 2 + 1] - lam * TMPF[DV + lane * 2 + 1];
    const float rstd = rsqrtf(wave_sum(d0 * d0 + d1 * d1) * (1.f / DV) + EPS) * (1.f - LAMBDA_INIT);
    bf16* AT = (bf16*)(P.ws + WS_ATTN);
    *(unsigned*)(AT + (size_t)(b * SEQ + q) * AW + h * DV + lane * 2) = pk2(d0 * rstd * P.subln_w[lane * 2], d1 * rstd * P.subln_w[lane * 2 + 1]);
}
__global__ void __launch_bounds__(256) nk_merge(Ptrs P) {
    __shared__ float ar[4][AW]; __shared__ float cr[4][CW];
    const int t0 = blockIdx.x * 4, tid = threadIdx.x;
    const bf16* AT = (const bf16*)(P.ws + WS_ATTN); const bf16* CF = (const bf16*)(P.ws + WS_CF);
    for (int i = tid; i < 4 * AW; i += 256) { ar[i >> 9][i & 511] = bf2f(AT[(size_t)t0 * AW + i]); cr[i >> 9][i & 511] = bf2f(CF[(size_t)t0 * CW + i]); }
    __syncthreads();
    const bf16* SG = (const bf16*)P.out; bf16* MG = (bf16*)(P.ws + WS_MG);
    for (int n = tid; n < DM; n += 256) {
        float a[4] = {0.f, 0.f, 0.f, 0.f}, c[4] = {0.f, 0.f, 0.f, 0.f};
        for (int k = 0; k < AW; ++k) { const float wa = P.w_pa[(size_t)k * DM + n], wb = P.w_pb[(size_t)k * DM + n];
#pragma unroll
            for (int r = 0; r < 4; ++r) { a[r] += ar[r][k] * wa; c[r] += cr[r][k] * wb; } }
#pragma unroll
        for (int r = 0; r < 4; ++r) { const size_t o = (size_t)(t0 + r) * DM + n;
            MG[o] = (bf16)f2bf(bf2f(SG[o]) * a[r] + bf2f(SG[(size_t)NTOK * DM + o]) * c[r]); }
    }
}
__global__ void __launch_bounds__(256) nk_wo(Ptrs P) {
    __shared__ float ar[4][DM];
    const int t0 = blockIdx.x * 4, tid = threadIdx.x;
    const bf16* MG = (const bf16*)(P.ws + WS_MG);
    for (int i = tid; i < 4 * DM; i += 256) ar[i >> 10][i & 1023] = bf2f(MG[(size_t)t0 * DM + i]);
    __syncthreads();
    float* H = (float*)(P.ws + WS_H);
    for (int n = tid; n < DM; n += 256) {
        float a[4] = {0.f, 0.f, 0.f, 0.f};
        for (int k = 0; k < DM; ++k) { const float w = P.w_o[(size_t)k * DM + n];
#pragma unroll
            for (int r = 0; r < 4; ++r) a[r] += ar[r][k] * w; }
#pragma unroll
        for (int r = 0; r < 4; ++r) { const size_t o = (size_t)(t0 + r) * DM + n; H[o] = P.x[o] + a[r]; }
    }
}
__global__ void __launch_bounds__(512) nk_hn(Ptrs P) { p5_hn(P, blockIdx.x * 8 + (threadIdx.x >> 6), gridDim.x * 8, threadIdx.x & 63); }
__global__ void __launch_bounds__(256) nk_wq(Ptrs P) {
    __shared__ float ar[4][DM];
    const int t0 = blockIdx.x * 4, tid = threadIdx.x;
    const bf16* HN = (const bf16*)(P.ws + WS_HN);
    for (int i = tid; i < 4 * DM; i += 256) ar[i >> 10][i & 1023] = bf2f(HN[(size_t)t0 * DM + i]);
    __syncthreads();
    bf16* QP = (bf16*)(P.ws + WS_QP);
    for (int n = tid; n < QPW; n += 256) {
        float a[4] = {0.f, 0.f, 0.f, 0.f};
        for (int k = 0; k < DM; ++k) { const float w = P.w_query[(size_t)k * QPW + n];
#pragma unroll
            for (int r = 0; r < 4; ++r) a[r] += ar[r][k] * w; }
#pragma unroll
        for (int r = 0; r < 4; ++r) QP[(size_t)(t0 + r) * QPW + n] = (bf16)f2bf(a[r]);
    }
}
__device__ __forceinline__ unsigned f2h(float f) { _Float16 h = (_Float16)f; return (unsigned)__builtin_bit_cast(unsigned short, h); }
__device__ __forceinline__ float h2f(unsigned u) { return (float)__builtin_bit_cast(_Float16, (unsigned short)(u & 0xffffu)); }
__global__ void __launch_bounds__(64) nk_topk(Ptrs P) {
    extern __shared__ __attribute__((aligned(16))) unsigned char ldsraw[];
    float* sc = (float*)ldsraw + threadIdx.x * 256;
    float* tv = (float*)ldsraw + 64 * 256 + threadIdx.x * 32;
    int* ti = (int*)((float*)ldsraw + 64 * 256 + 64 * 32) + threadIdx.x * 32;
    const int gid = blockIdx.x * 64 + threadIdx.x, t = gid >> 3, hd = gid & 7;
    const bf16* QP = (const bf16*)(P.ws + WS_QP) + (size_t)t * QPW + hd * 256;
    for (int p = 0; p < 2; ++p)
        for (int n = 0; n < NKEY; ++n) { const float* key = P.sub_keys + ((size_t)(hd * 2 + p) * NKEY + n) * PHD; float s = 0.f;
            for (int d = 0; d < PHD; ++d) s += bf2f(QP[p * 128 + d]) * key[d];
            sc[p * 128 + n] = s; }
    for (int p = 0; p < 2; ++p)
        for (int r = 0; r < TOPK; ++r) { float best = -3e38f; int bi = 0;
            for (int n = 0; n < NKEY; ++n) { const float v = sc[p * 128 + n]; if (v > best) { best = v; bi = n; } }
            tv[p * 16 + r] = best; ti[p * 16 + r] = bi; sc[p * 128 + bi] = -3e38f; }
    for (int i = 0; i < 16; ++i) for (int j = 0; j < 16; ++j) sc[i * 16 + j] = tv[i] + tv[16 + j];
    float top[16]; int eid[16];
#pragma unroll
    for (int r = 0; r < TOPK; ++r) { float best = -3e38f; int bi = 0;
        for (int n = 0; n < 256; ++n) { const float v = sc[n]; if (v > best) { best = v; bi = n; } }
        top[r] = best; eid[r] = ti[bi >> 4] * NKEY + ti[16 + (bi & 15)]; sc[bi] = -3e38f; }
    float sum = 0.f; const float tmax = top[0];
#pragma unroll
    for (int r = 0; r < TOPK; ++r) { top[r] = expf(top[r] - tmax); sum += top[r]; }
    unsigned* SEL = (unsigned*)(P.ws + WS_SEL) + (size_t)t * 128 + hd * 16;
#pragma unroll
    for (int r = 0; r < TOPK; ++r) SEL[r] = ((unsigned)eid[r] << 16) | f2h(top[r] / sum);
}
__global__ void __launch_bounds__(256) nk_peer(Ptrs P) {
    __shared__ float hn[DM]; __shared__ float wk[128]; __shared__ int ek[128]; __shared__ float red[4];
    const int t = blockIdx.x, tid = threadIdx.x;
    const bf16* HN = (const bf16*)(P.ws + WS_HN) + (size_t)t * DM;
    for (int i = tid; i < DM; i += 256) hn[i] = bf2f(HN[i]);
    __syncthreads();
    if (tid < 128) { const unsigned s = ((const unsigned*)(P.ws + WS_SEL))[(size_t)t * 128 + tid]; const int e = s >> 16; const float g = h2f(s);
        const float* u = P.expert_u + (size_t)e * DM; float a = 0.f;
        for (int d = 0; d < DM; ++d) a += u[d] * hn[d];
        const float ge = 0.5f * a * (1.f + erff(a * 0.70710678118654752f));
        wk[tid] = g * ge; ek[tid] = e; }
    __syncthreads();
    const float* H = (const float*)(P.ws + WS_H) + (size_t)t * DM;
    float y[4]; float ss = 0.f;
#pragma unroll
    for (int r = 0; r < 4; ++r) { const int d = tid + 256 * r; float o = 0.f;
        for (int k = 0; k < 128; ++k) o += wk[k] * P.expert_v[(size_t)ek[k] * DM + d];
        y[r] = H[d] + o; ss += y[r] * y[r]; }
    ss = wave_sum(ss);
    if ((tid & 63) == 0) red[tid >> 6] = ss;
    __syncthreads();
    const float rstd = rsqrtf((red[0] + red[1] + red[2] + red[3]) * (1.f / DM) + EPS);
#pragma unroll
    for (int r = 0; r < 4; ++r) { const int d = tid + 256 * r; P.out[(size_t)t * DM + d] = y[r] * rstd * P.final_norm_w[d]; }
}
namespace pg8 {
#define PG8_LAS __attribute__((address_space(3)))
typedef unsigned short bf16_t;
typedef short bf16x8 __attribute__((ext_vector_type(8)));
typedef float f32x4 __attribute__((ext_vector_type(4)));
typedef unsigned u32x4 __attribute__((ext_vector_type(4)));
constexpr int BM = 256, BK = 64, HALF = 128, HTB = HALF * BK * 2  , STAGE_BYTES = 8 * HTB, NXCD = 8, WGM = 8;

__host__ __device__ __forceinline__ int lds_byte(int r, int c) { const int st = (r >> 4) * 2 + (c >> 5), rr = r & 15, cc = c & 31, ob = rr * 64 + cc * 2; return st * 1024 + (ob ^ (((ob >> 9) & 1) << 5)); }
__host__ __device__ __forceinline__ void stage_rc(int b, int& R, int& C) { const int st = b / 1024, sb = b % 1024, swz = sb ^ (((sb >> 9) & 1) << 5); R = (st >> 1) * 16 + swz / 64; C = (st & 1) * 32 + (swz % 64) / 2; }
__host__ __device__ __forceinline__ int perm32(int rho) { const int n = rho >> 4, i = rho & 15; return 8 * (i >> 2) + 4 * n + (i & 3); }

struct Unit { int pm, pn; };
struct Gemm { const bf16_t* A; const bf16_t* Bt; int M, N, K; };

struct StaticOrder {
    int nM, nN, nwg, G, c;
    __host__ __device__ void init(int M, int N, int G_, int c_) { nM = M / BM; nN = N / BM; nwg = nM * nN; G = G_; c = c_; }
    __host__ __device__ bool next(int i, Unit& u) const {
        const long L = (long)i * G + c; if (L >= nwg) return false;
        int wgid = (int)L; { const int q = nwg / NXCD, r = nwg % NXCD, xcd = wgid % NXCD, off = wgid / NXCD; wgid = (xcd < r ? xcd * (q + 1) : r * (q + 1) + (xcd - r) * q) + off; }
        const int nig = WGM * nN, gid = wgid / nig, fm = gid * WGM, gsz = (nM - fm) < WGM ? (nM - fm) : WGM;
        u.pm = fm + ((wgid % nig) % gsz); u.pn = (wgid % nig) / gsz; return true;
    }
    __device__ __forceinline__ void a_ready(const Unit&) const {}
    __device__ __forceinline__ void done(const Unit&) const {}
};

__device__ __forceinline__ unsigned cvt_pk_bf16(float lo, float hi) { unsigned r; asm volatile("v_cvt_pk_bf16_f32 %0, %1, %2" : "=v"(r) : "v"(lo), "v"(hi)); return r; }
template <class Epi, class Sched, bool ALIGN_EPI = false, bool SP2 = false>
__device__ __forceinline__ void gemm_phase(PG8_LAS unsigned char* lds, const Gemm g, const Sched& S, const Epi& E) {
    const int tid = threadIdx.x, wid = __builtin_amdgcn_readfirstlane(tid >> 6), lane = tid & 63, wr = wid >> 2, wc = wid & 3, fr = lane & 15, fq = lane >> 4;
    const int K = g.K, nt = K / BK;
    unsigned voffA[2], voffB[2];
#pragma unroll
    for (int i = 0; i < 2; ++i) { int R, C; stage_rc(tid * 16 + i * 8192, R, C); const int Rb = Epi::PERM ? ((R & ~31) + perm32(R & 31)) : R;
        voffA[i] = (unsigned)(R * K + C) * 2u; voffB[i] = (unsigned)(Rb * K + C) * 2u; }
    const size_t kstep = (size_t)(BK * 2);
    const size_t hstep = (size_t)HALF * K * 2;
    const size_t tstep = 2 * hstep;
    const unsigned ldsw = (unsigned)wid * 1024u;
    const int aoff = lds_byte(wr * 64 + fr, fq * 8), boff = lds_byte(wc * 32 + fr, fq * 8);
#define PG8_SA(b, h) (((b) * 2 + (h)) * HTB)
#define PG8_SB(b, h) ((4 + (b) * 2 + (h)) * HTB)
#define PG8_STAGE(bufoff, gbase, voff) do { _Pragma("unroll") for (int _i = 0; _i < 2; ++_i) \
        __builtin_amdgcn_global_load_lds((const unsigned*)((const char*)(gbase) + (voff)[_i]), (PG8_LAS unsigned*)(lds + (bufoff) + ldsw + _i * 8192), 16, 0, 0); } while (0)
#define PG8_LDA(dst, b, h) do { _Pragma("unroll") for (int m = 0; m < 4; ++m) _Pragma("unroll") for (int k = 0; k < 2; ++k) dst[m][k] = *(const PG8_LAS bf16x8*)(lds + PG8_SA(b, h) + aoff + m * 2048 + k * 1024); } while (0)
#define PG8_LDB(dst, b, h) do { _Pragma("unroll") for (int n = 0; n < 2; ++n) _Pragma("unroll") for (int k = 0; k < 2; ++k) dst[n][k] = *(const PG8_LAS bf16x8*)(lds + PG8_SB(b, h) + boff + n * 2048 + k * 1024); } while (0)
#define PG8_MMA(ai, bj, At, Bt) do { __builtin_amdgcn_s_setprio(1); _Pragma("unroll") for (int m = 0; m < 4; ++m) _Pragma("unroll") for (int n = 0; n < 2; ++n) _Pragma("unroll") for (int k = 0; k < 2; ++k) \
        acc[ai][bj][m][n] = __builtin_amdgcn_mfma_f32_16x16x32_bf16(Bt[n][k], At[m][k], acc[ai][bj][m][n], 0, 0, 0); __builtin_amdgcn_s_setprio(0); } while (0)
#define PG8_WAIT_V(n) asm volatile("s_waitcnt vmcnt(" #n ")" ::: "memory")
#define PG8_WAIT_L(n) asm volatile("s_waitcnt lgkmcnt(" #n ")" ::: "memory")
#define PG8_BAR __builtin_amdgcn_s_barrier()
#define PG8_SCHED __builtin_amdgcn_sched_barrier(0)
    Unit cur, nxt; int ui = 0;
    if (!S.next(0, cur)) return;
    f32x4 acc[2][2][4][2];
#pragma unroll
    for (int a = 0; a < 2; ++a)
#pragma unroll
        for (int b = 0; b < 2; ++b)
#pragma unroll
            for (int m = 0; m < 4; ++m)
#pragma unroll
                for (int n = 0; n < 2; ++n) acc[a][b][m][n] = (f32x4){0.f, 0.f, 0.f, 0.f};
    bf16x8 At[4][2], B0[2][2], B1[2][2];
    const char* cA = (const char*)g.A + (size_t)cur.pm * tstep; const char* cB = (const char*)g.Bt + (size_t)cur.pn * tstep;
    S.a_ready(cur);
    if constexpr (SP2) {
        PG8_STAGE(PG8_SB(0, 0), cB, voffB); PG8_STAGE(PG8_SB(0, 1), cB + hstep, voffB); PG8_STAGE(PG8_SA(0, 0), cA, voffA); PG8_STAGE(PG8_SA(0, 1), cA + hstep, voffA);
        if (wr == 1) PG8_BAR;
        PG8_WAIT_V(2); PG8_BAR;
        PG8_STAGE(PG8_SB(1, 0), cB + kstep, voffB); PG8_STAGE(PG8_SA(1, 0), cA + kstep, voffA); PG8_STAGE(PG8_SB(1, 1), cB + hstep + kstep, voffB);
        PG8_WAIT_V(6); PG8_BAR;
    } else {
        PG8_STAGE(PG8_SB(0, 0), cB, voffB); PG8_STAGE(PG8_SA(0, 0), cA, voffA); PG8_STAGE(PG8_SB(0, 1), cB + hstep, voffB); PG8_STAGE(PG8_SA(0, 1), cA + hstep, voffA);
        if (wr == 1) PG8_BAR;
        PG8_WAIT_V(4); PG8_BAR;
        PG8_STAGE(PG8_SB(1, 0), cB + kstep, voffB); PG8_STAGE(PG8_SA(1, 0), cA + kstep, voffA); PG8_STAGE(PG8_SB(1, 1), cB + hstep + kstep, voffB);
        PG8_WAIT_V(6); PG8_BAR;
    }
    for (;;) {
        const bool has_next = S.next(ui + 1, nxt);
        const char* nA = has_next ? (const char*)g.A + (size_t)nxt.pm * tstep : cA; const char* nB = has_next ? (const char*)g.Bt + (size_t)nxt.pn * tstep : cB;
        for (int t = 0; t < nt; t += 2) {
            const bool last = (t == nt - 2);
            const char* a1 = cA + (size_t)(t + 1) * kstep;
            const char* a2 = last ? nA : cA + (size_t)(t + 2) * kstep; const char* b2 = last ? nB : cB + (size_t)(t + 2) * kstep;
            const char* a3 = a2 + kstep; const char* b3 = b2 + kstep;
            if (last && has_next) S.a_ready(nxt);
            if constexpr (SP2) {
            PG8_LDB(B0, 0, 0); PG8_LDB(B1, 0, 1); PG8_SCHED; PG8_LDA(At, 0, 0); PG8_STAGE(PG8_SA(1, 1), a1 + hstep, voffA);
            PG8_WAIT_V(8); PG8_WAIT_L(0); PG8_BAR; PG8_MMA(0, 0, At, B0); PG8_MMA(0, 1, At, B1); PG8_BAR; PG8_SCHED;
            PG8_LDA(At, 0, 1); PG8_STAGE(PG8_SB(0, 0), b2, voffB); PG8_STAGE(PG8_SB(0, 1), b2 + hstep, voffB); PG8_STAGE(PG8_SA(0, 0), a2, voffA);
            PG8_WAIT_V(8); PG8_WAIT_L(0); PG8_BAR; PG8_MMA(1, 0, At, B0); PG8_MMA(1, 1, At, B1); PG8_BAR; PG8_SCHED;
            PG8_LDB(B0, 1, 0); PG8_LDB(B1, 1, 1); PG8_SCHED; PG8_LDA(At, 1, 0); PG8_STAGE(PG8_SA(0, 1), a2 + hstep, voffA);
            PG8_WAIT_V(8); PG8_WAIT_L(0); PG8_BAR; PG8_MMA(0, 0, At, B0); PG8_MMA(0, 1, At, B1); PG8_BAR; PG8_SCHED;
            PG8_LDA(At, 1, 1); PG8_STAGE(PG8_SB(1, 0), b3, voffB); PG8_STAGE(PG8_SB(1, 1), b3 + hstep, voffB); PG8_STAGE(PG8_SA(1, 0), a3, voffA);
            PG8_WAIT_V(8); PG8_WAIT_L(0); PG8_BAR; PG8_MMA(1, 0, At, B0); PG8_MMA(1, 1, At, B1); PG8_BAR; PG8_SCHED;
            } else {
            PG8_LDB(B0, 0, 0); PG8_SCHED; PG8_LDA(At, 0, 0); PG8_STAGE(PG8_SA(1, 1), a1 + hstep, voffA);
            PG8_WAIT_L(8); PG8_BAR; PG8_WAIT_L(0); PG8_MMA(0, 0, At, B0); PG8_BAR; PG8_SCHED;
            PG8_LDB(B1, 0, 1); PG8_STAGE(PG8_SB(0, 0), b2, voffB);
            PG8_BAR; PG8_WAIT_L(0); PG8_MMA(0, 1, At, B1); PG8_BAR;
            PG8_LDA(At, 0, 1); PG8_STAGE(PG8_SA(0, 0), a2, voffA);
            PG8_BAR; PG8_WAIT_L(0); PG8_MMA(1, 0, At, B0); PG8_BAR; PG8_SCHED;
            PG8_STAGE(PG8_SB(0, 1), b2 + hstep, voffB);
            PG8_WAIT_V(6); PG8_BAR; PG8_MMA(1, 1, At, B1); PG8_BAR;
            PG8_LDB(B0, 1, 0); PG8_SCHED; PG8_LDA(At, 1, 0); PG8_STAGE(PG8_SA(0, 1), a2 + hstep, voffA);
            PG8_WAIT_L(8); PG8_BAR; PG8_WAIT_L(0); PG8_MMA(0, 0, At, B0); PG8_BAR; PG8_SCHED;
            PG8_LDB(B1, 1, 1); PG8_STAGE(PG8_SB(1, 0), b3, voffB);
            PG8_BAR; PG8_WAIT_L(0); PG8_MMA(0, 1, At, B1); PG8_BAR;
            PG8_LDA(At, 1, 1); PG8_STAGE(PG8_SA(1, 0), a3, voffA);
            PG8_BAR; PG8_WAIT_L(0); PG8_MMA(1, 0, At, B0); PG8_BAR; PG8_SCHED;
            PG8_STAGE(PG8_SB(1, 1), b3 + hstep, voffB);
            PG8_WAIT_V(6); PG8_BAR; PG8_MMA(1, 1, At, B1); PG8_BAR;
            }
        }
        if constexpr (ALIGN_EPI) { if (wr == 0) PG8_BAR; }
        if constexpr (!Epi::AFTER_DRAIN) { E(acc, cur, wr, wc, fr, fq); S.done(cur); }
        if (!has_next) break;
#pragma unroll
        for (int a = 0; a < 2; ++a)
#pragma unroll
            for (int b = 0; b < 2; ++b)
#pragma unroll
                for (int m = 0; m < 4; ++m)
#pragma unroll
                    for (int n = 0; n < 2; ++n) acc[a][b][m][n] = (f32x4){0.f, 0.f, 0.f, 0.f};
        cur = nxt; cA = nA; cB = nB; ++ui;
        if constexpr (ALIGN_EPI) { if (wr == 1) PG8_BAR; }
    }
    PG8_WAIT_V(0);
    if constexpr (!ALIGN_EPI) { if (wr == 0) PG8_BAR; }
    PG8_BAR;
    if constexpr (Epi::AFTER_DRAIN) { E.fused(acc, cur, wr, wc, fr, fq, lds, wid, lane); S.done(cur); }
#undef PG8_SA
#undef PG8_SB
#undef PG8_STAGE
#undef PG8_LDA
#undef PG8_LDB
#undef PG8_MMA
#undef PG8_WAIT_V
#undef PG8_WAIT_L
#undef PG8_BAR
#undef PG8_SCHED
}
}
namespace pg8 {
__device__ __forceinline__ float fast_sigmoid(float v) { return __builtin_amdgcn_rcpf(1.f + __expf(-v)); }
struct EpiInProj {
    static constexpr bool PERM = true, AFTER_DRAIN = false;
    unsigned char* ws; bf16_t* sg; const float* COS; const float* SIN;
    __device__ __forceinline__ void operator()(const f32x4 (&acc)[2][2][4][2], const Unit& u, int wr, int wc, int fr, int fq) const {
        const int pn = u.pn, row0 = u.pm * BM + wr * 64 + fr, cw = wc * 32 + 8 * fq;
#pragma unroll
        for (int ai = 0; ai < 2; ++ai)
#pragma unroll
            for (int m = 0; m < 4; ++m) {
                const int row = row0 + ai * HALF + m * 16, bb = row >> 12, pos = row & 4095, tile = pos >> 6, kvr = pos & 63;
                if (pn < 4) {
                    const int i0 = (cw & 63) >> 1;
                    const f32x4 cs = *(const f32x4*)(COS + pos * 32 + i0), sn = *(const f32x4*)(SIN + pos * 32 + i0);
#pragma unroll
                    for (int bj = 0; bj < 2; ++bj) {
                        const f32x4 v0 = acc[ai][bj][m][0], v1 = acc[ai][bj][m][1];
                        float o[8];
                        o[0] = v0[0] * cs[0] - v0[1] * sn[0]; o[1] = v0[1] * cs[0] + v0[0] * sn[0];
                        o[2] = v0[2] * cs[1] - v0[3] * sn[1]; o[3] = v0[3] * cs[1] + v0[2] * sn[1];
                        o[4] = v1[0] * cs[2] - v1[1] * sn[2]; o[5] = v1[1] * cs[2] + v1[0] * sn[2];
                        o[6] = v1[2] * cs[3] - v1[3] * sn[3]; o[7] = v1[3] * cs[3] + v1[2] * sn[3];
                        const int cq = (pn & 1) * 256 + bj * HALF + cw;
                        u32x4 w;
                        if (pn < 2) { w.x = cvt_pk_bf16(o[0] * C2, o[1] * C2); w.y = cvt_pk_bf16(o[2] * C2, o[3] * C2); w.z = cvt_pk_bf16(o[4] * C2, o[5] * C2); w.w = cvt_pk_bf16(o[6] * C2, o[7] * C2);
                            *(u32x4*)((bf16_t*)(ws + WS_Q) + (size_t)row * QKW + cq) = w; }
                        else { w.x = cvt_pk_bf16(o[0], o[1]); w.y = cvt_pk_bf16(o[2], o[3]); w.z = cvt_pk_bf16(o[4], o[5]); w.w = cvt_pk_bf16(o[6], o[7]);
                            const int g = cq >> 6; *(u32x4*)(ws + WS_KV + kv_tile_off(bb, g >> 1, tile) + k_img_off(g & 1, kvr, cq & 63)) = w; }
                    }
                } else {
#pragma unroll
                    for (int bj = 0; bj < 2; ++bj) {
                        f32x4 v0 = acc[ai][bj][m][0], v1 = acc[ai][bj][m][1];
                        if (pn >= 12) {
#pragma unroll
                            for (int q = 0; q < 4; ++q) { v0[q] = fast_sigmoid(v0[q]); v1[q] = fast_sigmoid(v1[q]); } }
                        u32x4 w; w.x = cvt_pk_bf16(v0[0], v0[1]); w.y = cvt_pk_bf16(v0[2], v0[3]); w.z = cvt_pk_bf16(v1[0], v1[1]); w.w = cvt_pk_bf16(v1[2], v1[3]);
                        if (pn < 6) { const int ce = (pn - 4) * 256 + bj * HALF + cw; *(u32x4*)(ws + WS_KV + kv_tile_off(bb, ce >> 7, tile) + v_img_off(kvr, ce & 127)) = w; }
                        else if (pn < 12) { const int jj = (pn - 6) * 256 + bj * HALF + cw, which = jj >> 9, cc = jj & 511;
                            *(u32x4*)((bf16_t*)(ws + (which == 0 ? WS_BG : which == 1 ? WS_CG : WS_XC)) + (size_t)row * CW + cc) = w; }
                        else { const int jj = (pn - 12) * 256 + bj * HALF + cw, which = jj >> 10, cc = jj & 1023;
                            *(u32x4*)(sg + (size_t)which * NTOK * DM + (size_t)row * DM + cc) = w; }
                    }
                }
            }
    }
};
template <int SECOND> struct EpiGate {
    static constexpr bool PERM = true, AFTER_DRAIN = false;
    const bf16_t* gate; const bf16_t* prev; bf16_t* O;
    __device__ __forceinline__ void operator()(const f32x4 (&acc)[2][2][4][2], const Unit& u, int wr, int wc, int fr, int fq) const {
        const int row0 = u.pm * BM + wr * 64 + fr, col0 = u.pn * BM + wc * 32 + 8 * fq;
#pragma unroll
        for (int ai = 0; ai < 2; ++ai)
#pragma unroll
            for (int m = 0; m < 4; ++m) {
                const size_t ro = (size_t)(row0 + ai * HALF + m * 16) * DM + col0;
#pragma unroll
                for (int bj = 0; bj < 2; ++bj) {
                    const f32x4 v0 = acc[ai][bj][m][0], v1 = acc[ai][bj][m][1];
                    const u32x4 g = *(const u32x4*)(gate + ro + bj * HALF);
                    float o[8];
                    o[0] = bflo(g.x) * v0[0]; o[1] = bfhi(g.x) * v0[1]; o[2] = bflo(g.y) * v0[2]; o[3] = bfhi(g.y) * v0[3];
                    o[4] = bflo(g.z) * v1[0]; o[5] = bfhi(g.z) * v1[1]; o[6] = bflo(g.w) * v1[2]; o[7] = bfhi(g.w) * v1[3];
                    if (SECOND) { const u32x4 p = *(const u32x4*)(prev + ro + bj * HALF);
                        o[0] += bflo(p.x); o[1] += bfhi(p.x); o[2] += bflo(p.y); o[3] += bfhi(p.y); o[4] += bflo(p.z); o[5] += bfhi(p.z); o[6] += bflo(p.w); o[7] += bfhi(p.w); }
                    u32x4 w; w.x = cvt_pk_bf16(o[0], o[1]); w.y = cvt_pk_bf16(o[2], o[3]); w.z = cvt_pk_bf16(o[4], o[5]); w.w = cvt_pk_bf16(o[6], o[7]);
                    *(u32x4*)(O + ro + bj * HALF) = w;
                }
            }
    }
};
struct EpiResid {
    static constexpr bool PERM = false, AFTER_DRAIN = false;
    const float* base; float* C;
    __device__ __forceinline__ void operator()(const f32x4 (&acc)[2][2][4][2], const Unit& u, int wr, int wc, int fr, int fq) const {
        const int row0 = u.pm * BM + wr * 64 + fr, col0 = u.pn * BM + wc * 32 + 4 * fq;
#pragma unroll
        for (int ai = 0; ai < 2; ++ai)
#pragma unroll
            for (int m = 0; m < 4; ++m) { const size_t ro = (size_t)(row0 + ai * HALF + m * 16) * DM + col0;
#pragma unroll
                for (int bj = 0; bj < 2; ++bj)
#pragma unroll
                    for (int n = 0; n < 2; ++n) *(f32x4*)(C + ro + bj * HALF + n * 16) = acc[ai][bj][m][n] + *(const f32x4*)(base + ro + bj * HALF + n * 16); }
    }
};
struct EpiPlainBf16 {
    static constexpr bool PERM = true, AFTER_DRAIN = false;
    bf16_t* O; int ldc;
    __device__ __forceinline__ void operator()(const f32x4 (&acc)[2][2][4][2], const Unit& u, int wr, int wc, int fr, int fq) const {
        const int row0 = u.pm * BM + wr * 64 + fr, col0 = u.pn * BM + wc * 32 + 8 * fq;
#pragma unroll
        for (int ai = 0; ai < 2; ++ai)
#pragma unroll
            for (int m = 0; m < 4; ++m) { bf16_t* rowp = O + (size_t)(row0 + ai * HALF + m * 16) * ldc + col0;
#pragma unroll
                for (int bj = 0; bj < 2; ++bj) { const f32x4 v0 = acc[ai][bj][m][0], v1 = acc[ai][bj][m][1];
                    u32x4 w; w.x = cvt_pk_bf16(v0[0], v0[1]); w.y = cvt_pk_bf16(v0[2], v0[3]); w.z = cvt_pk_bf16(v1[0], v1[1]); w.w = cvt_pk_bf16(v1[2], v1[3]);
                    *(u32x4*)(rowp + bj * HALF) = w; } }
    }
};
}

constexpr int NWAVES = 8;
constexpr int RING_BYTES = 131072, LDSCTL_OFF = RING_BYTES, MISC_OFF = LDSCTL_OFF + 320, LDS_BYTES = 147456;
constexpr int CW_BAR = 4096;
#define RLX_AGENT __ATOMIC_RELAXED, __HIP_MEMORY_SCOPE_AGENT
#define XB_TMO      128
#define XB_XCNT(j)  (256  + 64 * (j))
#define XB_XSUB(j)  (1280 + 64 * (j))
#define XB_XGEN(j)  (2304 + 64 * (j))
#define XB_TOP      3328
#define XB_TOPGEN   3392
#define XCD_BAR_WORDS 3456
#define XB_SPIN_CAP (1u << 18)

__device__ __forceinline__ unsigned xb_ld(unsigned* p)              { return __hip_atomic_load(p, __ATOMIC_RELAXED, __HIP_MEMORY_SCOPE_AGENT); }
__device__ __forceinline__ unsigned xb_add(unsigned* p, unsigned v) { return __hip_atomic_fetch_add(p, v, __ATOMIC_RELAXED, __HIP_MEMORY_SCOPE_AGENT); }
__device__ __forceinline__ unsigned xb_xcc_id() { return (unsigned)__builtin_amdgcn_s_getreg((3 << 11) | 20) & 0xFu; }
#define XB_SPIN(cond, bar) do { unsigned _sp = 0; while (cond) { __builtin_amdgcn_s_sleep(1); \
    if ((++_sp & 255u) == 0u) { if (xb_ld(&(bar)[XB_TMO])) break; if (_sp > XB_SPIN_CAP) { atomicAdd(&(bar)[XB_TMO], 1u); break; } } } } while (0)

struct XcdBarrier {
    unsigned* bar; unsigned x;
    volatile LAS unsigned* st;
};

__device__ __forceinline__ XcdBarrier xcd_barrier_post(unsigned* bar, volatile LAS unsigned* st) {
    XcdBarrier b; b.bar = bar; b.x = xb_xcc_id(); b.st = st;
    if (threadIdx.x == 0) (void)xb_add(&bar[XB_XCNT(b.x)], 1u);
    return b;
}
__device__ __forceinline__ void xcd_barrier_complete(unsigned* bar, unsigned x, unsigned& nloc, unsigned& nx) {
    const unsigned G = gridDim.x * gridDim.y * gridDim.z;
    unsigned sum, cnt, mine, sp = 0u;
    for (;;) {
        sum = 0u; cnt = 0u; mine = 0u;
#pragma unroll
        for (unsigned j = 0; j < 16; ++j) { const unsigned c = xb_ld(&bar[XB_XCNT(j)]); sum += c; cnt += (c > 0u) ? 1u : 0u; mine = (j == x) ? c : mine; }
        if (sum == G) break;
        __builtin_amdgcn_s_sleep(1);
        if ((++sp & 255u) == 0u) { if (xb_ld(&bar[XB_TMO])) break; if (sp > XB_SPIN_CAP) { atomicAdd(&bar[XB_TMO], 1u); break; } }
    }
    nloc = mine > 0u ? mine : 1u; nx = cnt > 0u ? cnt : 1u;
}

__device__ __forceinline__ void xcd_barrier(const XcdBarrier& b) {
    asm volatile("s_waitcnt vmcnt(0)" ::: "memory");
    __syncthreads();
    if (threadIdx.x == 0) {
        unsigned* bar = b.bar;
        __builtin_amdgcn_s_waitcnt(0);
        unsigned nloc = b.st[0], nx = b.st[1];
        if (nloc == 0u) { xcd_barrier_complete(bar, b.x, nloc, nx); b.st[0] = nloc; b.st[1] = nx; }
        const unsigned old = xb_add(&bar[XB_XSUB(b.x)], 1u);
        const unsigned gen = old / nloc;
        if (old + 1u == (gen + 1u) * nloc) {
            __builtin_amdgcn_fence(__ATOMIC_RELEASE, "agent");
            asm volatile("s_waitcnt vmcnt(0)" ::: "memory");
            const unsigned og = xb_add(&bar[XB_TOP], 1u);
            const unsigned tg = og / nx;
            if (og + 1u == (tg + 1u) * nx) xb_add(&bar[XB_TOPGEN], 1u);
            else XB_SPIN(xb_ld(&bar[XB_TOPGEN]) == tg, bar);
            __builtin_amdgcn_fence(__ATOMIC_ACQUIRE, "agent");
            xb_add(&bar[XB_XGEN(b.x)], 1u);
            asm volatile("s_waitcnt vmcnt(0)" ::: "memory");
        } else {
            XB_SPIN(xb_ld(&bar[XB_XGEN(b.x)]) == gen, bar);
            __builtin_amdgcn_fence(__ATOMIC_ACQUIRE, "agent");
            asm volatile("s_waitcnt vmcnt(0)" ::: "memory");
        }
    }
    __syncthreads();
}
namespace att {
typedef short v4i16_t __attribute__((ext_vector_type(4)));
constexpr int KVBUF = 32768, QF_OFF = 2 * KVBUF, WSF_OFF = 131072 + 1024, OST_OFF = 0;
constexpr float THR = 8.0f;
__device__ __forceinline__ int crow(int r, int hi) { return (r & 3) + 8 * (r >> 2) + 4 * hi; }
__device__ __forceinline__ float halves_max(float v) { auto rr = __builtin_amdgcn_permlane32_swap(__float_as_uint(v), __float_as_uint(v), false, false); return fmaxf(__uint_as_float(rr[0]), __uint_as_float(rr[1])); }
__device__ __forceinline__ float halves_sum(float v) { auto rr = __builtin_amdgcn_permlane32_swap(__float_as_uint(v), __float_as_uint(v), false, false); return __uint_as_float(rr[0]) + __uint_as_float(rr[1]); }
__device__ __forceinline__ unsigned cvtpk(float lo, float hi) { typedef float f2 __attribute__((ext_vector_type(2))); typedef __bf16 b2 __attribute__((ext_vector_type(2))); f2 v = {lo, hi}; b2 b = __builtin_convertvector(v, b2); return __builtin_bit_cast(unsigned, b); }

__device__ __forceinline__ void attn_unit(const Ptrs& P, LAS unsigned char* L, int b, int h, int qb, float lam, int wave, int lane) {
    int r32 = lane & 31, hi = lane >> 5;
    const unsigned char* kvbase = P.ws + WS_KV + kv_tile_off(b, h, 0);
    LAS float* wsf = (LAS float*)(L + WSF_OFF) + wave * 64;
#define ATT_DMA(t, bufoff) do { _Pragma("unroll") for (int j_ = 0; j_ < 4; ++j_) { const int piece_ = wave * 4 + j_; \
        __builtin_amdgcn_global_load_lds((const unsigned*)(kvbase + (size_t)(t) * 32768 + piece_ * 1024 + lane * 16), (LAS unsigned*)(L + (bufoff) + piece_ * 1024), 16, 0, 0); } } while (0)
    ATT_DMA(0, 0);
    LAS unsigned char* qfl = L + QF_OFF + wave * 8192 + lane * 16;
    { const bf16* Qw = (const bf16*)(P.ws + WS_Q) + (size_t)(b * SEQ + qb * 256 + wave * 32 + r32) * QKW + h * 128 + hi * 8;
#pragma unroll
      for (int m = 0; m < 2; ++m)
#pragma unroll
          for (int d0 = 0; d0 < 4; ++d0) *(LAS bf16x8*)(qfl + (m * 4 + d0) * 1024) = *(const bf16x8*)(Qw + m * 64 + d0 * 16); }
    f32x16 o[2][4];
#pragma unroll
    for (int m = 0; m < 2; ++m)
#pragma unroll
        for (int k = 0; k < 4; ++k) o[m][k] = f32x16{};
    float mhat[2] = {-1e30f, -1e30f}, lsum[2] = {0.f, 0.f};
    const int vlane = 16384 + ((lane >> 4) & 1) * 32 + (lane & 3) * 8 + (4 * hi + ((lane & 15) >> 2)) * 64;
    asm volatile("s_waitcnt vmcnt(0)" ::: "memory"); __syncthreads();
    for (int t = 0; t < 64; ++t) {
        const int cur = (t & 1) * KVBUF;
        if (t + 1 < 64) ATT_DMA(t + 1, KVBUF - cur);
        bf16x8 pa[2][4];
#pragma unroll
        for (int m = 0; m < 2; ++m) {
            f32x16 p0 = f32x16{}, p1 = f32x16{};
            const LAS unsigned char* kb = L + cur + m * 8192 + hi * 1024 + r32 * 16;
#pragma unroll
            for (int d0 = 0; d0 < 4; ++d0) {
                const bf16x8 k0 = *(const LAS bf16x8*)(kb + d0 * 2048), k1 = *(const LAS bf16x8*)(kb + d0 * 2048 + 512);
                const bf16x8 q = *(const LAS bf16x8*)(qfl + (m * 4 + d0) * 1024);
                p0 = __builtin_amdgcn_mfma_f32_32x32x16_bf16(k0, q, p0, 0, 0, 0);
                p1 = __builtin_amdgcn_mfma_f32_32x32x16_bf16(k1, q, p1, 0, 0, 0);
            }
            float rm = fmaxf(p0[0], p1[0]);
#pragma unroll
            for (int r = 1; r < 16; ++r) rm = fmaxf(rm, fmaxf(p0[r], p1[r]));
            rm = halves_max(rm);
            if (__any(rm > mhat[m] + THR)) {
                const float mn = fmaxf(mhat[m], rm), f = __builtin_amdgcn_exp2f(mhat[m] - mn);
                mhat[m] = mn; lsum[m] *= f;
                if (hi == 0) wsf[r32] = f;
                asm volatile("s_waitcnt lgkmcnt(0)" ::: "memory");
#pragma unroll
                for (int r = 0; r < 16; ++r) { const float fr = wsf[crow(r, hi)];
#pragma unroll
                    for (int k = 0; k < 4; ++k) o[m][k][r] *= fr; }
                asm volatile("s_waitcnt lgkmcnt(0)" ::: "memory");
            }
            const float mh = mhat[m]; float ls = 0.f;
#pragma unroll
            for (int r = 0; r < 16; ++r) { p0[r] = __builtin_amdgcn_exp2f(p0[r] - mh); p1[r] = __builtin_amdgcn_exp2f(p1[r] - mh); ls += p0[r] + p1[r]; }
            lsum[m] += ls;
            { u32x4 w;
              w.x = cvtpk(p0[0], p0[1]); w.y = cvtpk(p0[2], p0[3]); w.z = cvtpk(p0[4], p0[5]); w.w = cvtpk(p0[6], p0[7]); pa[m][0] = __builtin_bit_cast(bf16x8, w);
              w.x = cvtpk(p0[8], p0[9]); w.y = cvtpk(p0[10], p0[11]); w.z = cvtpk(p0[12], p0[13]); w.w = cvtpk(p0[14], p0[15]); pa[m][1] = __builtin_bit_cast(bf16x8, w);
              w.x = cvtpk(p1[0], p1[1]); w.y = cvtpk(p1[2], p1[3]); w.z = cvtpk(p1[4], p1[5]); w.w = cvtpk(p1[6], p1[7]); pa[m][2] = __builtin_bit_cast(bf16x8, w);
              w.x = cvtpk(p1[8], p1[9]); w.y = cvtpk(p1[10], p1[11]); w.z = cvtpk(p1[12], p1[13]); w.w = cvtpk(p1[14], p1[15]); pa[m][3] = __builtin_bit_cast(bf16x8, w); }
        }
        { const LAS unsigned char* vb = L + cur + vlane;
#pragma unroll
          for (int blk = 0; blk < 4; ++blk)
#pragma unroll
              for (int ks = 0; ks < 4; ++ks) {
                  const v4i16_t lo = __builtin_amdgcn_ds_read_tr16_b64_v4i16((LAS v4i16_t*)(vb + blk * 4096 + ks * 1024));
                  const v4i16_t hv = __builtin_amdgcn_ds_read_tr16_b64_v4i16((LAS v4i16_t*)(vb + blk * 4096 + ks * 1024 + 512));
                  const bf16x8 vf = (bf16x8){lo[0], lo[1], lo[2], lo[3], hv[0], hv[1], hv[2], hv[3]};
                  o[0][blk] = __builtin_amdgcn_mfma_f32_32x32x16_bf16(pa[0][ks], vf, o[0][blk], 0, 0, 0);
                  o[1][blk] = __builtin_amdgcn_mfma_f32_32x32x16_bf16(pa[1][ks], vf, o[1][blk], 0, 0, 0);
              } }
        asm volatile("s_waitcnt vmcnt(0) lgkmcnt(0)" ::: "memory"); __syncthreads();
    }
#undef ATT_DMA
    asm volatile("" : "+v"(lane));
    r32 = lane & 31; hi = lane >> 5;
    const float l0 = halves_sum(lsum[0]), l1 = halves_sum(lsum[1]);
    if (hi == 0) { wsf[r32] = 1.f / l0; wsf[32 + r32] = lam / l1; }
    asm volatile("s_waitcnt lgkmcnt(0)" ::: "memory");
    float ss[16];
#pragma unroll
    for (int r = 0; r < 16; ++r) { const float a = wsf[crow(r, hi)], c = wsf[32 + crow(r, hi)]; float s = 0.f;
#pragma unroll
        for (int k = 0; k < 4; ++k) { const float d = o[0][k][r] * a - o[1][k][r] * c; o[0][k][r] = d; s += d * d; }
        ss[r] = s; }
#pragma unroll
    for (int r = 0; r < 16; ++r) {
#pragma unroll
        for (int x = 1; x < 32; x <<= 1) ss[r] += __shfl_xor(ss[r], x);
        ss[r] = rsqrtf(ss[r] * (1.f / DV) + EPS) * (1.f - LAMBDA_INIT); }
    LAS bf16* stg = (LAS bf16*)(L + OST_OFF) + wave * 4096;
#pragma unroll
    for (int k = 0; k < 4; ++k) { const float sw = P.subln_w[k * 32 + r32];
#pragma unroll
        for (int r = 0; r < 16; ++r) stg[crow(r, hi) * 128 + k * 32 + r32] = (bf16)f2bf(o[0][k][r] * ss[r] * sw); }
    asm volatile("s_waitcnt lgkmcnt(0)" ::: "memory");
    bf16* AT = (bf16*)(P.ws + WS_ATTN) + (size_t)(b * SEQ + qb * 256 + wave * 32) * AW + h * DV;
#pragma unroll
    for (int i = 0; i < 8; ++i) { const int row = i * 4 + (lane >> 4), ch = lane & 15;
        const u32x4 v = *(const LAS u32x4*)(stg + row * 128 + ch * 8); *(u32x4*)(AT + (size_t)row * AW + ch * 8) = v; }
    asm volatile("s_waitcnt lgkmcnt(0)" ::: "memory"); __syncthreads();
}
__device__ __forceinline__ void attn_phase(const Ptrs& P, LAS unsigned char* L, int vcu, int G, int wave, int lane) {
    const float lam = lam_value(P);
    for (int u = vcu; u < NB * NH * 16; u += G) attn_unit(P, L, u >> 6, (u >> 4) & 3, u & 15, lam, wave, lane);
}
}
namespace tk {
constexpr int KEYS_LDS = 0, IDX_LDS = 65536;
__device__ __forceinline__ unsigned umax(unsigned a, unsigned b) { return a > b ? a : b; }
__device__ __forceinline__ unsigned umin(unsigned a, unsigned b) { return a < b ? a : b; }
__device__ __forceinline__ unsigned f2sort(float f) { const unsigned u = __float_as_uint(f); return u ^ ((unsigned)((int)u >> 31) | 0x80000000u); }
__device__ __forceinline__ float sort2f(unsigned s) { const unsigned u = (s & 0x80000000u) ? (s ^ 0x80000000u) : ~s; return __uint_as_float(u); }
__device__ __forceinline__ unsigned partner32(unsigned v, int hi) { auto rr = __builtin_amdgcn_permlane32_swap(v, v, false, false); return hi ? rr[0] : rr[1]; }
__device__ __forceinline__ void sort16_desc(unsigned* x) {
#pragma unroll
    for (int k = 2; k <= 16; k <<= 1)
#pragma unroll
        for (int j = k >> 1; j > 0; j >>= 1)
#pragma unroll
            for (int i = 0; i < 16; ++i) { const int l = i ^ j; if (l > i) { const bool desc = ((i & k) == 0); const unsigned mx = umax(x[i], x[l]), mn = umin(x[i], x[l]); x[i] = desc ? mx : mn; x[l] = desc ? mn : mx; } }
}
__device__ __forceinline__ void merge16_desc(unsigned* a, const unsigned* b) {
#pragma unroll
    for (int i = 0; i < 16; ++i) a[i] = umax(a[i], b[15 - i]);
#pragma unroll
    for (int j = 8; j > 0; j >>= 1)
#pragma unroll
        for (int i = 0; i < 16; ++i) { const int l = i ^ j; if (l > i) { const unsigned mx = umax(a[i], a[l]), mn = umin(a[i], a[l]); a[i] = mx; a[l] = mn; } }
}
__device__ __forceinline__ void merge_partner(unsigned* a, int hi) {
    unsigned b[16];
#pragma unroll
    for (int i = 0; i < 16; ++i) b[i] = partner32(a[i], hi);
    merge16_desc(a, b);
}
__device__ __forceinline__ void topk_unit(const Ptrs& P, LAS unsigned char* L, int tb, int hd, int wave, int lane, int tid) {
    const int r32 = lane & 31, hi = lane >> 5;
    const int tok = tb * 256 + wave * 32 + r32;
    const bf16* QPr = (const bf16*)(P.ws + WS_QP) + (size_t)tok * QPW + hd * 256 + hi * 8;
    unsigned S[2][16];
#pragma unroll
    for (int p = 0; p < 2; ++p) {
        bf16x8 qf[8];
#pragma unroll
        for (int d0 = 0; d0 < 8; ++d0) qf[d0] = *(const bf16x8*)(QPr + p * 128 + d0 * 16);
        unsigned x[64];
#pragma unroll
        for (int kb = 0; kb < 4; ++kb) {
            f32x16 acc = f32x16{};
            const LAS unsigned char* ka = L + KEYS_LDS + p * 32768 + hi * 2048 + (kb * 32 + r32) * 16;
#pragma unroll
            for (int d0 = 0; d0 < 8; ++d0) acc = __builtin_amdgcn_mfma_f32_32x32x16_bf16(*(const LAS bf16x8*)(ka + d0 * 4096), qf[d0], acc, 0, 0, 0);
#pragma unroll
            for (int r = 0; r < 16; ++r) x[kb * 16 + r] = (f2sort(acc[r]) & ~127u) | (unsigned)(kb * 32 + (r & 3) + 8 * (r >> 2) + 4 * hi);
        }
        sort16_desc(x); sort16_desc(x + 16); sort16_desc(x + 32); sort16_desc(x + 48);
        merge16_desc(x, x + 16); merge16_desc(x + 32, x + 48); merge16_desc(x, x + 32);
        merge_partner(x, hi);
#pragma unroll
        for (int i = 0; i < 16; ++i) S[p][i] = x[i];
    }
    LAS unsigned char* ib = L + IDX_LDS + tid * 32;
#pragma unroll
    for (int p = 0; p < 2; ++p) {
        u32x4 w;
        w.x = (S[p][0] & 127u) | ((S[p][1] & 127u) << 8) | ((S[p][2] & 127u) << 16) | ((S[p][3] & 127u) << 24);
        w.y = (S[p][4] & 127u) | ((S[p][5] & 127u) << 8) | ((S[p][6] & 127u) << 16) | ((S[p][7] & 127u) << 24);
        w.z = (S[p][8] & 127u) | ((S[p][9] & 127u) << 8) | ((S[p][10] & 127u) << 16) | ((S[p][11] & 127u) << 24);
        w.w = (S[p][12] & 127u) | ((S[p][13] & 127u) << 8) | ((S[p][14] & 127u) << 16) | ((S[p][15] & 127u) << 24);
        *(LAS u32x4*)(ib + p * 16) = w;
    }
    float va[16], vb[16];
#pragma unroll
    for (int i = 0; i < 16; ++i) { const float v0 = sort2f(S[0][i] & ~127u), v1 = sort2f(S[1][i] & ~127u); va[i] = hi ? v1 : v0; vb[i] = hi ? v0 : v1; }
    unsigned c[32];
    { int n = 0;
#pragma unroll
      for (int i = 0; i < 16; ++i)
#pragma unroll
          for (int j = i; j < 16; ++j) if ((i + 1) * (j + 1) <= 16) {
              const unsigned code = hi ? (unsigned)(j * 16 + i) : (unsigned)(i * 16 + j);
              unsigned v = (f2sort(va[i] + vb[j]) & ~255u) | code;
              if (i == j) v = hi ? 0u : v;
              c[n] = v; ++n; }
#pragma unroll
      for (; n < 32; ++n) c[n] = 0u; }
    sort16_desc(c); sort16_desc(c + 16); merge16_desc(c, c + 16);
    merge_partner(c, hi);
    const float tmax = sort2f(c[0] & ~255u); const unsigned hmask = (unsigned)(-hi);
    float e[8]; unsigned cd[8]; float es = 0.f;
#pragma unroll
    for (int k = 0; k < 8; ++k) { const unsigned v = (c[k + 8] & hmask) | (c[k] & ~hmask); cd[k] = v & 255u; e[k] = __expf(sort2f(v & ~255u) - tmax); es += e[k]; }
    const float rs = 1.f / att::halves_sum(es);
    asm volatile("s_waitcnt lgkmcnt(0)" ::: "memory");
    unsigned o[8];
#pragma unroll
    for (int k = 0; k < 8; ++k) { const unsigned i1 = ib[cd[k] >> 4], i2 = ib[16 + (cd[k] & 15u)]; o[k] = ((i1 * 128u + i2) << 16) | f2h(e[k] * rs); }
    unsigned* SEL = (unsigned*)(P.ws + WS_SEL) + (size_t)tok * 128 + hd * 16 + hi * 8;
    *(u32x4*)SEL = (u32x4){o[0], o[1], o[2], o[3]}; *(u32x4*)(SEL + 4) = (u32x4){o[4], o[5], o[6], o[7]};
}
__device__ __forceinline__ void topk_phase(const Ptrs& P, LAS unsigned char* L, int vcu, int G, int wave, int lane, int tid) {
    const int hd = vcu & 7;
    { const int key = tid & 127, p = (tid >> 7) & 1, cg = tid >> 8;
      const bf16* src = (const bf16*)(P.ws + WS_KEYS) + ((size_t)(hd * 2 + p) * NKEY + key) * PHD + cg * 64;
      u32x4 v[8];
#pragma unroll
      for (int i = 0; i < 8; ++i) v[i] = *(const u32x4*)(src + i * 8);
#pragma unroll
      for (int i = 0; i < 8; ++i) *(LAS u32x4*)(L + KEYS_LDS + p * 32768 + (cg * 8 + i) * 2048 + key * 16) = v[i]; }
    asm volatile("s_waitcnt lgkmcnt(0)" ::: "memory"); __syncthreads();
    for (int tb = vcu >> 3; tb < NTOK / 256; tb += (G >> 3)) topk_unit(P, L, tb, hd, wave, lane, tid);
    asm volatile("s_waitcnt lgkmcnt(0)" ::: "memory"); __syncthreads();
}
}
namespace pe {
__device__ __forceinline__ f32x2 fp8lo(unsigned w) { return __builtin_amdgcn_cvt_pk_f32_fp8((int)w, false); }
__device__ __forceinline__ f32x2 fp8hi(unsigned w) { return __builtin_amdgcn_cvt_pk_f32_fp8((int)w, true); }
__device__ __forceinline__ float dot16(const u32x4& u, const f32x2* h) {
    f32x2 a = fp8lo(u.x) * h[0]; a += fp8hi(u.x) * h[1]; a += fp8lo(u.y) * h[2]; a += fp8hi(u.y) * h[3];
    a += fp8lo(u.z) * h[4]; a += fp8hi(u.z) * h[5]; a += fp8lo(u.w) * h[6]; a += fp8hi(u.w) * h[7];
    return a.x + a.y;
}
__device__ __forceinline__ void axpy16(float w, const u32x4& v, f32x2* o) {
    const f32x2 ww = {w, w};
    o[0] += ww * fp8lo(v.x); o[1] += ww * fp8hi(v.x); o[2] += ww * fp8lo(v.y); o[3] += ww * fp8hi(v.y);
    o[4] += ww * fp8lo(v.z); o[5] += ww * fp8hi(v.z); o[6] += ww * fp8lo(v.w); o[7] += ww * fp8hi(v.w);
}
__device__ __forceinline__ void peer_token(const Ptrs& P, int tok, int lane) {
    const unsigned char* EU = P.ws + WS_EU; const unsigned char* EV = P.ws + WS_EV; const float* SC = (const float*)(P.ws + WS_SCU);
    const unsigned* SEL = (const unsigned*)(P.ws + WS_SEL) + (size_t)tok * 128;
    const unsigned e0 = SEL[lane], e1 = SEL[64 + lane];
    const unsigned char* hrow = P.ws + WS_HN + (size_t)tok * (DM * 2) + lane * 32;
    const u32x4 hA = *(const u32x4*)hrow, hB = *(const u32x4*)(hrow + 16);
    f32x2 h[8];
    h[0] = (f32x2){bflo(hA.x), bfhi(hA.x)}; h[1] = (f32x2){bflo(hA.y), bfhi(hA.y)}; h[2] = (f32x2){bflo(hA.z), bfhi(hA.z)}; h[3] = (f32x2){bflo(hA.w), bfhi(hA.w)};
    h[4] = (f32x2){bflo(hB.x), bfhi(hB.x)}; h[5] = (f32x2){bflo(hB.y), bfhi(hB.y)}; h[6] = (f32x2){bflo(hB.z), bfhi(hB.z)}; h[7] = (f32x2){bflo(hB.w), bfhi(hB.w)};
    f32x2 out[8];
#pragma unroll
    for (int i = 0; i < 8; ++i) out[i] = (f32x2){0.f, 0.f};
    float part[16];
    float wcur = 0.f;
    const int loff = lane * 16;
#define PE_U_GROUP(bt, g) do { u32x4 ua_[8]; \
        _Pragma("unroll") for (int q_ = 0; q_ < 8; ++q_) { const int k_ = (bt) * 16 + (g) * 8 + q_; const unsigned es_ = __builtin_amdgcn_readlane((k_ < 64) ? e0 : e1, k_ & 63); \
            ua_[q_] = *(const u32x4*)(EU + (size_t)(es_ >> 16) * DM + loff); } \
        _Pragma("unroll") for (int q_ = 0; q_ < 8; ++q_) part[(g) * 8 + q_] = dot16(ua_[q_], h); } while (0)
#define PE_REDUCE(bt) do { float v8_[8], v4_[4], v2_[2]; \
        { const bool b_ = lane & 1; _Pragma("unroll") for (int i_ = 0; i_ < 8; ++i_) { const float keep_ = b_ ? part[2 * i_ + 1] : part[2 * i_], send_ = b_ ? part[2 * i_] : part[2 * i_ + 1]; v8_[i_] = keep_ + __shfl_xor(send_, 1); } } \
        { const bool b_ = lane & 2; _Pragma("unroll") for (int i_ = 0; i_ < 4; ++i_) { const float keep_ = b_ ? v8_[2 * i_ + 1] : v8_[2 * i_], send_ = b_ ? v8_[2 * i_] : v8_[2 * i_ + 1]; v4_[i_] = keep_ + __shfl_xor(send_, 2); } } \
        { const bool b_ = lane & 4; _Pragma("unroll") for (int i_ = 0; i_ < 2; ++i_) { const float keep_ = b_ ? v4_[2 * i_ + 1] : v4_[2 * i_], send_ = b_ ? v4_[2 * i_] : v4_[2 * i_ + 1]; v2_[i_] = keep_ + __shfl_xor(send_, 4); } } \
        float a_; { const bool b_ = lane & 8; const float keep_ = b_ ? v2_[1] : v2_[0], send_ = b_ ? v2_[0] : v2_[1]; a_ = keep_ + __shfl_xor(send_, 8); } \
        a_ += __shfl_xor(a_, 16); a_ += __shfl_xor(a_, 32); \
        const unsigned eg_ = __shfl(((bt) < 4) ? e0 : e1, ((bt) & 3) * 16 + (lane & 15)); \
        a_ *= SC[eg_ >> 16]; \
        wcur = h2f(eg_) * (0.5f * a_ * (1.f + erff(a_ * 0.70710678118654752f))) * SC[NEXP + (eg_ >> 16)]; } while (0)
    PE_U_GROUP(0, 0); PE_U_GROUP(0, 1);
    for (int bt = 0; bt < 8; ++bt) {
        float w; PE_REDUCE(bt); w = wcur;
#pragma unroll
        for (int g = 0; g < 2; ++g) {
            u32x4 va[8];
#pragma unroll
            for (int q = 0; q < 8; ++q) { const int k = bt * 16 + g * 8 + q; const unsigned es = __builtin_amdgcn_readlane((k < 64) ? e0 : e1, k & 63);
                va[q] = *(const u32x4*)(EV + (size_t)(es >> 16) * DM + loff); }
            if (bt < 7) PE_U_GROUP(bt + 1, g);
#pragma unroll
            for (int q = 0; q < 8; ++q) { const float wk = __builtin_bit_cast(float, __builtin_amdgcn_readlane(__builtin_bit_cast(unsigned, w), g * 8 + q)); axpy16(wk, va[q], out); }
        }
    }
#undef PE_U_GROUP
#undef PE_REDUCE
    const float* hr = (const float*)(P.ws + WS_H) + (size_t)tok * DM + lane * 16;
    f32x4 y[4]; float ss = 0.f;
#pragma unroll
    for (int i = 0; i < 4; ++i) { y[i] = *(const f32x4*)(hr + 4 * i) + (f32x4){out[2 * i].x, out[2 * i].y, out[2 * i + 1].x, out[2 * i + 1].y}; ss += (y[i].x * y[i].x + y[i].y * y[i].y) + (y[i].z * y[i].z + y[i].w * y[i].w); }
    const float rstd = rsqrtf(wave_sum(ss) * (1.f / DM) + EPS);
    const float* fw = P.final_norm_w + lane * 16;
    float* orow = P.out + (size_t)tok * DM + lane * 16;
#pragma unroll
    for (int i = 0; i < 4; ++i) *(f32x4*)(orow + 4 * i) = y[i] * rstd * *(const f32x4*)(fw + 4 * i);
}
__device__ __forceinline__ void peer_phase(const Ptrs& P, int gw, int NGW, int lane) {
    for (int tok = gw; tok < NTOK; tok += NGW) peer_token(P, tok, lane);
}
}

struct Args { Ptrs P; int ph_lo, ph_hi, bar_region, pad; };
constexpr int N_PHASES = 9;

__global__ void __launch_bounds__(NWAVES * 64, 2) mk_fwd(Args args) {
    extern __shared__ __attribute__((aligned(16))) unsigned char lds[];
    LAS unsigned char* L = (LAS unsigned char*)lds;
    volatile LAS unsigned* MISC = (volatile LAS unsigned*)(L + MISC_OFF);
    const Ptrs& P = args.P;
    const int tid = threadIdx.x, lane = tid & 63, wave = __builtin_amdgcn_readfirstlane(tid >> 6);
    const int G = gridDim.x, bx = blockIdx.x, vcu = (G % 8 == 0) ? (bx % 8) * (G / 8) + bx / 8 : bx;
    const int gw = vcu * NWAVES + wave, NGW = G * NWAVES;
    unsigned char* ws = P.ws;
    unsigned* ctl = (unsigned*)(ws + WS_CTL);
    for (int u = tid; u < (LDS_BYTES - LDSCTL_OFF) / 4; u += NWAVES * 64) ((LAS unsigned*)(L + LDSCTL_OFF))[u] = 0u;
    __syncthreads();
    const int lo = args.ph_lo, hi = args.ph_hi;
    const bool multi = (hi - lo) > 1;
    unsigned* barw = ctl + CW_BAR + args.bar_region * XCD_BAR_WORDS;
    XcdBarrier bar; bar.bar = barw; bar.x = 0; bar.st = nullptr;
    if (multi) bar = xcd_barrier_post(barw, MISC + 8);
#ifndef REPEAT_MASK
#define REPEAT_MASK 0
#endif
#define IN(k) (lo <= (k) && (k) < hi)
#define REP(k) for (int rep_ = 0; rep_ < 1 + ((REPEAT_MASK >> (k)) & 1); ++rep_)
#define SEAM(k) do { if (IN(k) && IN((k) + 1)) xcd_barrier(bar); } while (0)

    if (IN(0)) REP(0) { p0_prologue(P, gw, NGW, lane, (LAS float*)L + wave * (64 * 33)); SEAM(0); }
    if (IN(1)) REP(1) {
        pg8::Gemm g{(const bf16*)(ws + WS_XN), (const bf16*)(ws + WS_WIN), NTOK, INW, DM}; pg8::StaticOrder S; S.init(NTOK, INW, G, bx);
        pg8::EpiInProj E{ws, (bf16*)P.out, (const float*)(ws + WS_ROPE), (const float*)(ws + WS_ROPE) + SEQ * 32};
        pg8::gemm_phase<pg8::EpiInProj, pg8::StaticOrder, true, true>(L, g, S, E);
        SEAM(1);
    }
    if (IN(2)) REP(2) { conv_rows(P, gw, NGW, lane); att::attn_phase(P, L, vcu, G, wave, lane); SEAM(2); }
    if (IN(3)) REP(3) {
        { pg8::Gemm g{(const bf16*)(ws + WS_ATTN), (const bf16*)(ws + WS_WPA), NTOK, DM, AW}; pg8::StaticOrder S; S.init(NTOK, DM, G, bx);
          pg8::EpiGate<0> E{(const bf16*)P.out, nullptr, (bf16*)(ws + WS_TMP)};
          pg8::gemm_phase<pg8::EpiGate<0>, pg8::StaticOrder, true, true>(L, g, S, E); }
        asm volatile("s_waitcnt vmcnt(0)" ::: "memory"); __syncthreads();
        { pg8::Gemm g{(const bf16*)(ws + WS_CF), (const bf16*)(ws + WS_WPB), NTOK, DM, CW}; pg8::StaticOrder S; S.init(NTOK, DM, G, bx);
          pg8::EpiGate<1> E{(const bf16*)P.out + (size_t)NTOK * DM, (const bf16*)(ws + WS_TMP), (bf16*)(ws + WS_MG)};
          pg8::gemm_phase<pg8::EpiGate<1>, pg8::StaticOrder, true, true>(L, g, S, E); }
        SEAM(3);
    }
    if (IN(4)) REP(4) {
        pg8::Gemm g{(const bf16*)(ws + WS_MG), (const bf16*)(ws + WS_WO), NTOK, DM, DM}; pg8::StaticOrder S; S.init(NTOK, DM, G, bx);
        pg8::EpiResid E{P.x, (float*)(ws + WS_H)};
        pg8::gemm_phase<pg8::EpiResid, pg8::StaticOrder, true, true>(L, g, S, E);
        SEAM(4);
    }
    if (IN(5)) REP(5) { p5_hn(P, gw, NGW, lane); SEAM(5); }
    if (IN(6)) REP(6) {
        pg8::Gemm g{(const bf16*)(ws + WS_HN), (const bf16*)(ws + WS_WQ), NTOK, QPW, DM}; pg8::StaticOrder S; S.init(NTOK, QPW, G, bx);
        pg8::EpiPlainBf16 E{(bf16*)(ws + WS_QP), QPW};
        pg8::gemm_phase<pg8::EpiPlainBf16, pg8::StaticOrder, true, true>(L, g, S, E);
        SEAM(6);
    }
    if (IN(7)) REP(7) { tk::topk_phase(P, L, vcu, G, wave, lane, tid); SEAM(7); }
    if (IN(8)) REP(8) { pe::peer_phase(P, gw, NGW, lane); }
#undef IN
#undef SEAM
}
static int g_grid = 0;
static void mk_launch(const Ptrs& P, int lo, int hi, int region, hipStream_t stream) {
    Args a{}; a.P = P; a.ph_lo = lo; a.ph_hi = hi; a.bar_region = region;
    void* params[] = {&a};
    hipError_t e = hipLaunchCooperativeKernel((const void*)mk_fwd, dim3(g_grid), dim3(NWAVES * 64), params, LDS_BYTES, stream);
    if (e != hipSuccess) fprintf(stderr, "mk launch failed: %s\n", hipGetErrorString(e));
}
extern "C" void kernel_launch(void* const* d_in, const int* in_sizes, int n_in, void* d_out, int out_size, void* d_ws, size_t ws_size, hipStream_t stream) {
    Ptrs P{};
    const float** pp = (const float**)&P;
    for (int i = 0; i < 18; ++i) pp[i] = (const float*)d_in[i];
    P.out = (float*)d_out; P.ws = (unsigned char*)d_ws;
    if (g_grid == 0) {
        (void)hipFuncSetAttribute((const void*)nk_prep, hipFuncAttributeMaxDynamicSharedMemorySize, 8 * 64 * 33 * 4);
        (void)hipFuncSetAttribute((const void*)nk_topk, hipFuncAttributeMaxDynamicSharedMemorySize, 64 * 320 * 4);
        (void)hipFuncSetAttribute((const void*)mk_fwd, hipFuncAttributeMaxDynamicSharedMemorySize, LDS_BYTES);
        int dev = 0, cus = 0, per_cu = 0;
        (void)hipGetDevice(&dev); (void)hipDeviceGetAttribute(&cus, hipDeviceAttributeMultiprocessorCount, dev);
        (void)hipOccupancyMaxActiveBlocksPerMultiprocessor(&per_cu, (const void*)mk_fwd, NWAVES * 64, LDS_BYTES);
        if (per_cu < 1) { fprintf(stderr, "occupancy query says %d blocks/CU\n", per_cu); per_cu = 1; }
        g_grid = cus * 1;
    }
    (void)hipMemsetAsync((char*)d_ws + WS_CTL, 0, CTL_BYTES, stream);
    mk_launch(P, 0, 9, 0, stream);
}
```

```cpp
#include <hip/hip_runtime.h>
#include <cstdint>
#include <cstdio>

constexpr int NB = 4, SEQ = 4096, DM = 1024, NTOK = NB * SEQ;
constexpr int NH = 4, DH = 64, DV = 128, QKW = 512, AW = 512, CW = 512;
constexpr int INW = 5120;
constexpr int PH = 8, NKEY = 128, PHD = 128, TOPK = 16, NEXP = 16384, QPW = 2048;
constexpr float EPS = 1e-6f;
constexpr float LAMBDA_INIT = 0.2f;
constexpr float C2 = 0.125f * 1.4426950408889634f;

constexpr size_t MiB = 1u << 20;
constexpr size_t WS_CTL = 0, CTL_BYTES = 1 * MiB;
constexpr size_t WS_WIN = 1 * MiB;
constexpr size_t WS_WPA = 11 * MiB;
constexpr size_t WS_WPB = 12 * MiB;
constexpr size_t WS_WO = 13 * MiB;
constexpr size_t WS_WQ = 15 * MiB;
constexpr size_t WS_KEYS = 19 * MiB;
constexpr size_t WS_ROPE = 20 * MiB;
constexpr size_t WS_EU = 21 * MiB;
constexpr size_t WS_EV = 37 * MiB;
constexpr size_t WS_SCU = 53 * MiB;
constexpr size_t WS_XN = 85 * MiB;
constexpr size_t WS_ATTN = 85 * MiB;
constexpr size_t WS_CF = 101 * MiB;
constexpr size_t WS_HN = 85 * MiB;
constexpr size_t WS_Q = 117 * MiB;
constexpr size_t WS_KV = 133 * MiB;
constexpr size_t WS_BG = 165 * MiB, WS_CG = 181 * MiB, WS_XC = 197 * MiB;
constexpr size_t WS_MG = 117 * MiB;
constexpr size_t WS_TMP = 149 * MiB;
constexpr size_t WS_H = 181 * MiB;
constexpr size_t WS_QP = 117 * MiB;
constexpr size_t WS_SEL = 245 * MiB;
constexpr size_t WS_END = 256 * MiB;

typedef unsigned short bf16;
typedef float f32x4 __attribute__((ext_vector_type(4)));
typedef float f32x16 __attribute__((ext_vector_type(16)));
typedef float f32x2 __attribute__((ext_vector_type(2)));
typedef unsigned u32x4 __attribute__((ext_vector_type(4)));
typedef unsigned u32x2 __attribute__((ext_vector_type(2)));
typedef short bf16x8 __attribute__((ext_vector_type(8)));
#define LAS __attribute__((address_space(3)))

__host__ __device__ __forceinline__ unsigned f2bf(float f) { unsigned u = __builtin_bit_cast(unsigned, f); return (u + 0x7fffu + ((u >> 16) & 1u)) >> 16; }
__host__ __device__ __forceinline__ unsigned pk2(float lo, float hi) { return f2bf(lo) | (f2bf(hi) << 16); }
__host__ __device__ __forceinline__ float bf2f(unsigned h) { return __builtin_bit_cast(float, (h & 0xffffu) << 16); }
__device__ __forceinline__ float bflo(unsigned w) { return __builtin_bit_cast(float, w << 16); }
__device__ __forceinline__ float bfhi(unsigned w) { return __builtin_bit_cast(float, w & 0xffff0000u); }

__host__ __device__ __forceinline__ size_t kv_tile_off(int b, int h, int tile) { return (size_t)((b * NH + h) * 64 + tile) * 32768; }
__host__ __device__ __forceinline__ int k_img_off(int m, int kvr, int p) { return m * 8192 + (p >> 3) * 1024 + kvr * 16 + (p & 7) * 2; }
__host__ __device__ __forceinline__ int v_img_off(int kvr, int e) { return 16384 + (e >> 5) * 4096 + (kvr >> 4) * 1024 + (kvr & 15) * 64 + (e & 31) * 2; }
struct Ptrs {
    const float *x, *attn_norm_w, *w_in, *lq1, *lk1, *lq2, *lk2, *subln_w, *conv_w, *w_pa, *w_pb, *w_o, *ffn_norm_w, *w_query, *sub_keys, *expert_u, *expert_v, *final_norm_w;
    float* out; unsigned char* ws;
};
__device__ __forceinline__ float wave_sum(float v) {
#pragma unroll
    for (int o = 1; o < 64; o <<= 1) v += __shfl_xor(v, o);
    return v;
}
__device__ __forceinline__ int rope_row(int c) { if (c < 1024) { const int g = c >> 6, d = c & 63; return (g << 6) + 2 * (d & 31) + (d >> 5); } return c; }
template <int MAP>
__device__ __forceinline__ void p0_transpose_item(const float* W, int K, int N, bf16* WT, LAS float* scr, int item, int lane) {
    const int nblk = N / 32, kb = item / nblk, nb = item % nblk, k0 = 64 * kb, n0 = 32 * nb;
#pragma unroll 8
    for (int i = 0; i < 32; ++i) { const int kk = 2 * i + (lane >> 5); scr[kk * 33 + (lane & 31)] = W[(size_t)(k0 + kk) * N + n0 + (lane & 31)]; }
    asm volatile("s_waitcnt lgkmcnt(0)" ::: "memory");
    const int c = lane & 7;
#pragma unroll
    for (int j = 0; j < 4; ++j) { const int n = (lane >> 3) + 8 * j; const LAS float* s = scr + (8 * c) * 33 + n;
        u32x4 o; o.x = pk2(s[0 * 33], s[1 * 33]); o.y = pk2(s[2 * 33], s[3 * 33]); o.z = pk2(s[4 * 33], s[5 * 33]); o.w = pk2(s[6 * 33], s[7 * 33]);
        const int drow = MAP ? rope_row(n0 + n) : (n0 + n);
        *(u32x4*)(WT + (size_t)drow * K + k0 + 8 * c) = o; }
    asm volatile("s_waitcnt lgkmcnt(0)" ::: "memory");
}
__device__ __forceinline__ void p0_cvt_chunk(const float* src, bf16* dst, int lane) {
    const f32x4 a = *(const f32x4*)(src + lane * 8), b = *(const f32x4*)(src + lane * 8 + 4);
    u32x4 o; o.x = pk2(a.x, a.y); o.y = pk2(a.z, a.w); o.z = pk2(b.x, b.y); o.w = pk2(b.z, b.w);
    *(u32x4*)(dst + lane * 8) = o;
}
__device__ __forceinline__ void rms_row_to_bf16(const float* xrow, const float* w, bf16* orow, int lane) {
    const f32x4* xr = (const f32x4*)xrow + lane; const f32x4* wr = (const f32x4*)w + lane;
    f32x4 v[4]; float s = 0.f;
#pragma unroll
    for (int j = 0; j < 4; ++j) { v[j] = xr[64 * j]; s += (v[j].x * v[j].x + v[j].y * v[j].y) + (v[j].z * v[j].z + v[j].w * v[j].w); }
    const float rstd = rsqrtf(wave_sum(s) * (1.f / DM) + EPS);
    unsigned long long* o8 = (unsigned long long*)orow + lane;
#pragma unroll
    for (int j = 0; j < 4; ++j) { const f32x4 ww = wr[64 * j];
        o8[64 * j] = (unsigned long long)pk2(v[j].x * rstd * ww.x, v[j].y * rstd * ww.y) | ((unsigned long long)pk2(v[j].z * rstd * ww.z, v[j].w * rstd * ww.w) << 32); }
}
__device__ __forceinline__ void p0_prologue(const Ptrs& P, int gw, int NGW, int lane, LAS float* scr) {
    unsigned char* ws = P.ws;
    bf16* WIN = (bf16*)(ws + WS_WIN); bf16* WPA = (bf16*)(ws + WS_WPA); bf16* WPB = (bf16*)(ws + WS_WPB); bf16* WO = (bf16*)(ws + WS_WO); bf16* WQ = (bf16*)(ws + WS_WQ);
    constexpr int I_IN = (DM / 64) * (INW / 32), I_PA = (AW / 64) * (DM / 32), I_PB = (CW / 64) * (DM / 32), I_O = (DM / 64) * (DM / 32), I_Q = (DM / 64) * (QPW / 32);
    constexpr int NITEMS = I_IN + I_PA + I_PB + I_O + I_Q;
    for (int it = gw; it < NITEMS; it += NGW) {
        int r = it;
        if (r < I_IN) { p0_transpose_item<1>(P.w_in, DM, INW, WIN, scr, r, lane); continue; } r -= I_IN;
        if (r < I_PA) { p0_transpose_item<0>(P.w_pa, AW, DM, WPA, scr, r, lane); continue; } r -= I_PA;
        if (r < I_PB) { p0_transpose_item<0>(P.w_pb, CW, DM, WPB, scr, r, lane); continue; } r -= I_PB;
        if (r < I_O) { p0_transpose_item<0>(P.w_o, DM, DM, WO, scr, r, lane); continue; } r -= I_O;
        p0_transpose_item<0>(P.w_query, DM, QPW, WQ, scr, r, lane);
    }
    constexpr int C_K = (PH * 2 * NKEY * PHD) / 512;
    for (int it = gw; it < C_K; it += NGW) p0_cvt_chunk(P.sub_keys + (size_t)it * 512, (bf16*)(ws + WS_KEYS) + (size_t)it * 512, lane);
    for (int it = gw; it < 2 * NEXP; it += NGW) {
        const int which = it >= NEXP, e = it - which * NEXP;
        const float* src = (which ? P.expert_v : P.expert_u) + (size_t)e * DM + lane * 16;
        f32x4 v[4]; float am = 0.f;
#pragma unroll
        for (int j = 0; j < 4; ++j) { v[j] = *(const f32x4*)(src + 4 * j); am = fmaxf(am, fmaxf(fmaxf(fabsf(v[j].x), fabsf(v[j].y)), fmaxf(fabsf(v[j].z), fabsf(v[j].w)))); }
#pragma unroll
        for (int o = 1; o < 64; o <<= 1) am = fmaxf(am, __shfl_xor(am, o));
        const float sc = am > 0.f ? 240.f / am : 1.f;
        u32x4 w;
#pragma unroll
        for (int j = 0; j < 4; ++j) { int t = 0; t = __builtin_amdgcn_cvt_pk_fp8_f32(v[j].x * sc, v[j].y * sc, t, false); t = __builtin_amdgcn_cvt_pk_fp8_f32(v[j].z * sc, v[j].w * sc, t, true); w[j] = (unsigned)t; }
        *(u32x4*)(ws + (which ? WS_EV : WS_EU) + (size_t)e * DM + lane * 16) = w;
        if (lane == 0) ((float*)(ws + WS_SCU))[which * NEXP + e] = 1.f / sc;
    }
    for (int m = gw; m < NTOK; m += NGW) rms_row_to_bf16(P.x + (size_t)m * DM, P.attn_norm_w, (bf16*)(ws + WS_XN) + (size_t)m * DM, lane);
    float* COS = (float*)(ws + WS_ROPE); float* SIN = COS + SEQ * 32;
    for (int e = gw * 64 + lane; e < SEQ * 32; e += NGW * 64) {
        const int pos = e >> 5, i = e & 31;
        const double inv = exp(-(double)i * (9.210340371976184 / 32.0));
        double s, c; sincos((double)pos * inv, &s, &c);
        COS[e] = (float)c; SIN[e] = (float)s;
    }
}
__device__ __forceinline__ void p5_hn(const Ptrs& P, int gw, int NGW, int lane) {
    for (int m = gw; m < NTOK; m += NGW) rms_row_to_bf16((const float*)(P.ws + WS_H) + (size_t)m * DM, P.ffn_norm_w, (bf16*)(P.ws + WS_HN) + (size_t)m * DM, lane);
}
__device__ __forceinline__ float lam_value(const Ptrs& P) {
    float a = 0.f, b = 0.f;
    for (int i = 0; i < DH; ++i) { a += P.lq1[i] * P.lk1[i]; b += P.lq2[i] * P.lk2[i]; }
    return expf(a) - expf(b) + LAMBDA_INIT;
}
__device__ __forceinline__ float sigmoidf_(float v) { return 1.f / (1.f + expf(-v)); }

__global__ void __launch_bounds__(512) nk_prep(Ptrs P) {
    extern __shared__ __attribute__((aligned(16))) unsigned char lds[];
    const int lane = threadIdx.x & 63, wave = threadIdx.x >> 6;
    p0_prologue(P, blockIdx.x * 8 + wave, gridDim.x * 8, lane, (LAS float*)lds + wave * (64 * 33));
}
__global__ void __launch_bounds__(256) nk_inproj(Ptrs P) {
    __shared__ float xr[4][DM];
    const int t0 = blockIdx.x * 4, tid = threadIdx.x;
    const bf16* XN = (const bf16*)(P.ws + WS_XN);
    for (int i = tid; i < 4 * DM; i += 256) xr[i >> 10][i & 1023] = bf2f(XN[(size_t)t0 * DM + i]);
    __syncthreads();
    const float* COS = (const float*)(P.ws + WS_ROPE); const float* SIN = COS + SEQ * 32;
    bf16* Q = (bf16*)(P.ws + WS_Q); unsigned char* KV = P.ws + WS_KV;
    bf16* SG = (bf16*)P.out;
    for (int j = tid; j < 4608; j += 256) {
        int c1, c2 = -1;
        if (j < 512) { c1 = (j >> 5) * 64 + (j & 31); c2 = c1 + 32; }
        else if (j < 1024) c1 = 1024 + (j - 512);
        else if (j < 2560) c1 = 1536 + (j - 1024);
        else c1 = 3072 + (j - 2560);
        float a0 = 0.f, a1 = 0.f, a2 = 0.f, a3 = 0.f, b0 = 0.f, b1 = 0.f, b2 = 0.f, b3 = 0.f;
        for (int k = 0; k < DM; ++k) {
            const float w1 = P.w_in[(size_t)k * INW + c1];
            a0 += xr[0][k] * w1; a1 += xr[1][k] * w1; a2 += xr[2][k] * w1; a3 += xr[3][k] * w1;
            if (c2 >= 0) { const float w2 = P.w_in[(size_t)k * INW + c2]; b0 += xr[0][k] * w2; b1 += xr[1][k] * w2; b2 += xr[2][k] * w2; b3 += xr[3][k] * w2; }
        }
#pragma unroll
        for (int r = 0; r < 4; ++r) {
            const float a = r == 0 ? a0 : r == 1 ? a1 : r == 2 ? a2 : a3, b = r == 0 ? b0 : r == 1 ? b1 : r == 2 ? b2 : b3;
            const int t = t0 + r, bb = t >> 12, pos = t & 4095, tile = pos >> 6, kvr = pos & 63;
            if (j < 512) {
                const int g = j >> 5, i = j & 31; const float cs = COS[pos * 32 + i], sn = SIN[pos * 32 + i];
                const float o1 = a * cs - b * sn, o2 = b * cs + a * sn;
                if (g < 8) { Q[(size_t)t * QKW + g * 64 + 2 * i] = (bf16)f2bf(o1 * C2); Q[(size_t)t * QKW + g * 64 + 2 * i + 1] = (bf16)f2bf(o2 * C2); }
                else { const int gk = g - 8, h = gk >> 1, m = gk & 1; unsigned char* tb = KV + kv_tile_off(bb, h, tile);
                    *(bf16*)(tb + k_img_off(m, kvr, 2 * i)) = (bf16)f2bf(o1); *(bf16*)(tb + k_img_off(m, kvr, 2 * i + 1)) = (bf16)f2bf(o2); }
            } else if (j < 1024) { const int ee = j - 512, h = ee >> 7, e = ee & 127; *(bf16*)(KV + kv_tile_off(bb, h, tile) + v_img_off(kvr, e)) = (bf16)f2bf(a); }
            else if (j < 2560) { const int jj = j - 1024, which = jj >> 9, cc = jj & 511; bf16* dst = (bf16*)(P.ws + (which == 0 ? WS_BG : which == 1 ? WS_CG : WS_XC)); dst[(size_t)t * CW + cc] = (bf16)f2bf(a); }
            else { const int jj = j - 2560, which = jj >> 10, cc = jj & 1023; SG[(size_t)which * NTOK * DM + (size_t)t * DM + cc] = (bf16)f2bf(sigmoidf_(a)); }
        }
    }
}
__device__ __forceinline__ void conv_rows(const Ptrs& P, int gw, int NGW, int lane) {
    const bf16* BG = (const bf16*)(P.ws + WS_BG); const bf16* CG = (const bf16*)(P.ws + WS_CG); const bf16* XC = (const bf16*)(P.ws + WS_XC); bf16* CF = (bf16*)(P.ws + WS_CF);
    for (int t = gw; t < NTOK; t += NGW) {
        const int pos = t & 4095; const size_t o = (size_t)t * CW + lane * 8;
        const u32x4 g = *(const u32x4*)(BG + o), c1 = *(const u32x4*)(CG + o), x1 = *(const u32x4*)(XC + o);
        u32x4 c0 = (u32x4){0, 0, 0, 0}, x0 = c0, c2 = c0, x2 = c0;
        if (pos > 0) { c0 = *(const u32x4*)(CG + o - CW); x0 = *(const u32x4*)(XC + o - CW); }
        if (pos < SEQ - 1) { c2 = *(const u32x4*)(CG + o + CW); x2 = *(const u32x4*)(XC + o + CW); }
        const f32x4 wa0 = *(const f32x4*)(P.conv_w + lane * 8), wa1 = *(const f32x4*)(P.conv_w + lane * 8 + 4);
        const f32x4 wb0 = *(const f32x4*)(P.conv_w + CW + lane * 8), wb1 = *(const f32x4*)(P.conv_w + CW + lane * 8 + 4);
        const f32x4 wc0 = *(const f32x4*)(P.conv_w + 2 * CW + lane * 8), wc1 = *(const f32x4*)(P.conv_w + 2 * CW + lane * 8 + 4);
        float r[8];
#pragma unroll
        for (int q = 0; q < 4; ++q) {
            const float w0l = q < 2 ? wa0[2 * q] : wa1[2 * q - 4], w0h = q < 2 ? wa0[2 * q + 1] : wa1[2 * q - 3];
            const float w1l = q < 2 ? wb0[2 * q] : wb1[2 * q - 4], w1h = q < 2 ? wb0[2 * q + 1] : wb1[2 * q - 3];
            const float w2l = q < 2 ? wc0[2 * q] : wc1[2 * q - 4], w2h = q < 2 ? wc0[2 * q + 1] : wc1[2 * q - 3];
            r[2 * q] = bflo(g[q]) * (w0l * bflo(c0[q]) * bflo(x0[q]) + w1l * bflo(c1[q]) * bflo(x1[q]) + w2l * bflo(c2[q]) * bflo(x2[q]));
            r[2 * q + 1] = bfhi(g[q]) * (w0h * bfhi(c0[q]) * bfhi(x0[q]) + w1h * bfhi(c1[q]) * bfhi(x1[q]) + w2h * bfhi(c2[q]) * bfhi(x2[q]));
        }
        u32x4 ov; ov.x = pk2(r[0], r[1]); ov.y = pk2(r[2], r[3]); ov.z = pk2(r[4], r[5]); ov.w = pk2(r[6], r[7]);
        *(u32x4*)(CF + o) = ov;
    }
}
__global__ void __launch_bounds__(512) nk_conv(Ptrs P) { conv_rows(P, blockIdx.x * 8 + (threadIdx.x >> 6), gridDim.x * 8, threadIdx.x & 63); }
__global__ void __launch_bounds__(256) nk_attn(Ptrs P) {
    const int gid = blockIdx.x * 256 + threadIdx.x;
    const int q = gid & 4095, eq = (gid >> 12) & 3, m = (gid >> 14) & 1, h = (gid >> 15) & 3, b = gid >> 17;
    const bf16* Q = (const bf16*)(P.ws + WS_Q); const unsigned char* KV = P.ws + WS_KV;
    const int t = b * SEQ + q;
    float qv[64];
#pragma unroll
    for (int p = 0; p < 64; ++p) qv[p] = bf2f(Q[(size_t)t * QKW + (h * 2 + m) * 64 + p]);
    float o[32];
#pragma unroll
    for (int e = 0; e < 32; ++e) o[e] = 0.f;
    float mx = -1e30f, l = 0.f;
    for (int kv = 0; kv < SEQ; ++kv) {
        const unsigned char* tb = KV + kv_tile_off(b, h, kv >> 6); const int kvr = kv & 63;
        float s = 0.f;
#pragma unroll
        for (int c = 0; c < 8; ++c) { const u32x4 kk = *(const u32x4*)(tb + k_img_off(m, kvr, c * 8));
#pragma unroll
            for (int w = 0; w < 4; ++w) s += qv[c * 8 + 2 * w] * bflo(kk[w]) + qv[c * 8 + 2 * w + 1] * bfhi(kk[w]); }
        if (s > mx) { const float f = exp2f(mx - s); l *= f;
#pragma unroll
            for (int e = 0; e < 32; ++e) o[e] *= f;
            mx = s; }
        const float p = exp2f(s - mx); l += p;
#pragma unroll
        for (int c = 0; c < 4; ++c) { const u32x4 vv = *(const u32x4*)(tb + v_img_off(kvr, eq * 32 + c * 8));
#pragma unroll
            for (int w = 0; w < 4; ++w) { o[c * 8 + 2 * w] += p * bflo(vv[w]); o[c * 8 + 2 * w + 1] += p * bfhi(vv[w]); } }
    }
    float* TMPF = (float*)(P.ws + WS_H);
    const float rl = 1.f / l;
#pragma unroll
    for (int e = 0; e < 32; ++e) TMPF[((size_t)((b * NH + h) * SEQ + q) * 2 + m) * DV + eq * 32 + e] = o[e] * rl;
}
__global__ void __launch_bounds__(256) nk_attn_fin(Ptrs P) {
    const int gw = blockIdx.x * 4 + (threadIdx.x >> 6), lane = threadIdx.x & 63;
    const int q = gw & 4095, h = (gw >> 12) & 3, b = gw >> 14;
    const float lam = lam_value(P);
    const float* TMPF = (const float*)(P.ws + WS_H) + (size_t)gw * 2 * DV;
    const float d0 = TMPF[lane * 2] - lam * TMPF[DV + lane * 2], d1 = TMPF[lane * 2 + 1] - lam * TMPF[DV + lane * 2 + 1];
    const float rstd = rsqrtf(wave_sum(d0 * d0 + d1 * d1) * (1.f / DV) + EPS) * (1.f - LAMBDA_INIT);
    bf16* AT = (bf16*)(P.ws + WS_ATTN);
    *(unsigned*)(AT + (size_t)(b * SEQ + q) * AW + h * DV + lane * 2) = pk2(d0 * rstd * P.subln_w[lane * 2], d1 * rstd * P.subln_w[lane * 2 + 1]);
}
__global__ void __launch_bounds__(256) nk_merge(Ptrs P) {
    __shared__ float ar[4][AW]; __shared__ float cr[4][CW];
    const int t0 = blockIdx.x * 4, tid = threadIdx.x;
    const bf16* AT = (const bf16*)(P.ws + WS_ATTN); const bf16* CF = (const bf16*)(P.ws + WS_CF);
    for (int i = tid; i < 4 * AW; i += 256) { ar[i >> 9][i & 511] = bf2f(AT[(size_t)t0 * AW + i]); cr[i >> 9][i & 511] = bf2f(CF[(size_t)t0 * CW + i]); }
    __syncthreads();
    const bf16* SG = (const bf16*)P.out; bf16* MG = (bf16*)(P.ws + WS_MG);
    for (int n = tid; n < DM; n += 256) {
        float a[4] = {0.f, 0.f, 0.f, 0.f}, c[4] = {0.f, 0.f, 0.f, 0.f};
        for (int k = 0; k < AW; ++k) { const float wa = P.w_pa[(size_t)k * DM + n], wb = P.w_pb[(size_t)k * DM + n];
#pragma unroll
            for (int r = 0; r < 4; ++r) { a[r] += ar[r][k] * wa; c[r] += cr[r][k] * wb; } }
#pragma unroll
        for (int r = 0; r < 4; ++r) { const size_t o = (size_t)(t0 + r) * DM + n;
            MG[o] = (bf16)f2bf(bf2f(SG[o]) * a[r] + bf2f(SG[(size_t)NTOK * DM + o]) * c[r]); }
    }
}
__global__ void __launch_bounds__(256) nk_wo(Ptrs P) {
    __shared__ float ar[4][DM];
    const int t0 = blockIdx.x * 4, tid = threadIdx.x;
    const bf16* MG = (const bf16*)(P.ws + WS_MG);
    for (int i = tid; i < 4 * DM; i += 256) ar[i >> 10][i & 1023] = bf2f(MG[(size_t)t0 * DM + i]);
    __syncthreads();
    float* H = (float*)(P.ws + WS_H);
    for (int n = tid; n < DM; n += 256) {
        float a[4] = {0.f, 0.f, 0.f, 0.f};
        for (int k = 0; k < DM; ++k) { const float w = P.w_o[(size_t)k * DM + n];
#pragma unroll
            for (int r = 0; r < 4; ++r) a[r] += ar[r][k] * w; }
#pragma unroll
        for (int r = 0; r < 4; ++r) { const size_t o = (size_t)(t0 + r) * DM + n; H[o] = P.x[o] + a[r]; }
    }
}
__global__ void __launch_bounds__(512) nk_hn(Ptrs P) { p5_hn(P, blockIdx.x * 8 + (threadIdx.x >> 6), gridDim.x * 8, threadIdx.x & 63); }
__global__ void __launch_bounds__(256) nk_wq(Ptrs P) {
    __shared__ float ar[4][DM];
    const int t0 = blockIdx.x * 4, tid = threadIdx.x;
    const bf16* HN = (const bf16*)(P.ws + WS_HN);
    for (int i = tid; i < 4 * DM; i += 256) ar[i >> 10][i & 1023] = bf2f(HN[(size_t)t0 * DM + i]);
    __syncthreads();
    bf16* QP = (bf16*)(P.ws + WS_QP);
    for (int n = tid; n < QPW; n += 256) {
        float a[4] = {0.f, 0.f, 0.f, 0.f};
        for (int k = 0; k < DM; ++k) { const float w = P.w_query[(size_t)k * QPW + n];
#pragma unroll
            for (int r = 0; r < 4; ++r) a[r] += ar[r][k] * w; }
#pragma unroll
        for (int r = 0; r < 4; ++r) QP[(size_t)(t0 + r) * QPW + n] = (bf16)f2bf(a[r]);
    }
}
__device__ __forceinline__ unsigned f2h(float f) { _Float16 h = (_Float16)f; return (unsigned)__builtin_bit_cast(unsigned short, h); }
__device__ __forceinline__ float h2f(unsigned u) { return (float)__builtin_bit_cast(_Float16, (unsigned short)(u & 0xffffu)); }
__global__ void __launch_bounds__(64) nk_topk(Ptrs P) {
    extern __shared__ __attribute__((aligned(16))) unsigned char ldsraw[];
    float* sc = (float*)ldsraw + threadIdx.x * 256;
    float* tv = (float*)ldsraw + 64 * 256 + threadIdx.x * 32;
    int* ti = (int*)((float*)ldsraw + 64 * 256 + 64 * 32) + threadIdx.x * 32;
    const int gid = blockIdx.x * 64 + threadIdx.x, t = gid >> 3, hd = gid & 7;
    const bf16* QP = (const bf16*)(P.ws + WS_QP) + (size_t)t * QPW + hd * 256;
    for (int p = 0; p < 2; ++p)
        for (int n = 0; n < NKEY; ++n) { const float* key = P.sub_keys + ((size_t)(hd * 2 + p) * NKEY + n) * PHD; float s = 0.f;
            for (int d = 0; d < PHD; ++d) s += bf2f(QP[p * 128 + d]) * key[d];
            sc[p * 128 + n] = s; }
    for (int p = 0; p < 2; ++p)
        for (int r = 0; r < TOPK; ++r) { float best = -3e38f; int bi = 0;
            for (int n = 0; n < NKEY; ++n) { const float v = sc[p * 128 + n]; if (v > best) { best = v; bi = n; } }
            tv[p * 16 + r] = best; ti[p * 16 + r] = bi; sc[p * 128 + bi] = -3e38f; }
    for (int i = 0; i < 16; ++i) for (int j = 0; j < 16; ++j) sc[i * 16 + j] = tv[i] + tv[16 + j];
    float top[16]; int eid[16];
#pragma unroll
    for (int r = 0; r < TOPK; ++r) { float best = -3e38f; int bi = 0;
        for (int n = 0; n < 256; ++n) { const float v = sc[n]; if (v > best) { best = v; bi = n; } }
        top[r] = best; eid[r] = ti[bi >> 4] * NKEY + ti[16 + (bi & 15)]; sc[bi] = -3e38f; }
    float sum = 0.f; const float tmax = top[0];
#pragma unroll
    for (int r = 0; r < TOPK; ++r) { top[r] = expf(top[r] - tmax); sum += top[r]; }
    unsigned* SEL = (unsigned*)(P.ws + WS_SEL) + (size_t)t * 128 + hd * 16;
#pragma unroll
    for (int r = 0; r < TOPK; ++r) SEL[r] = ((unsigned)eid[r] << 16) | f2h(top[r] / sum);
}
__global__ void __launch_bounds__(256) nk_peer(Ptrs P) {
    __shared__ float hn[DM]; __shared__ float wk[128]; __shared__ int ek[128]; __shared__ float red[4];
    const int t = blockIdx.x, tid = threadIdx.x;
    const bf16* HN = (const bf16*)(P.ws + WS_HN) + (size_t)t * DM;
    for (int i = tid; i < DM; i += 256) hn[i] = bf2f(HN[i]);
    __syncthreads();
    if (tid < 128) { const unsigned s = ((const unsigned*)(P.ws + WS_SEL))[(size_t)t * 128 + tid]; const int e = s >> 16; const float g = h2f(s);
        const float* u = P.expert_u + (size_t)e * DM; float a = 0.f;
        for (int d = 0; d < DM; ++d) a += u[d] * hn[d];
        const float ge = 0.5f * a * (1.f + erff(a * 0.70710678118654752f));
        wk[tid] = g * ge; ek[tid] = e; }
    __syncthreads();
    const float* H = (const float*)(P.ws + WS_H) + (size_t)t * DM;
    float y[4]; float ss = 0.f;
#pragma unroll
    for (int r = 0; r < 4; ++r) { const int d = tid + 256 * r; float o = 0.f;
        for (int k = 0; k < 128; ++k) o += wk[k] * P.expert_v[(size_t)ek[k] * DM + d];
        y[r] = H[d] + o; ss += y[r] * y[r]; }
    ss = wave_sum(ss);
    if ((tid & 63) == 0) red[tid >> 6] = ss;
    __syncthreads();
    const float rstd = rsqrtf((red[0] + red[1] + red[2] + red[3]) * (1.f / DM) + EPS);
#pragma unroll
    for (int r = 0; r < 4; ++r) { const int d = tid + 256 * r; P.out[(size_t)t * DM + d] = y[r] * rstd * P.final_norm_w[d]; }
}
namespace pg8 {
#define PG8_LAS __attribute__((address_space(3)))
typedef unsigned short bf16_t;
typedef short bf16x8 __attribute__((ext_vector_type(8)));
typedef float f32x4 __attribute__((ext_vector_type(4)));
typedef unsigned u32x4 __attribute__((ext_vector_type(4)));
constexpr int BM = 256, BK = 64, HALF = 128, HTB = HALF * BK * 2  , STAGE_BYTES = 8 * HTB, NXCD = 8, WGM = 8;

__host__ __device__ __forceinline__ int lds_byte(int r, int c) { const int st = (r >> 4) * 2 + (c >> 5), rr = r & 15, cc = c & 31, ob = rr * 64 + cc * 2; return st * 1024 + (ob ^ (((ob >> 9) & 1) << 5)); }
__host__ __device__ __forceinline__ void stage_rc(int b, int& R, int& C) { const int st = b / 1024, sb = b % 1024, swz = sb ^ (((sb >> 9) & 1) << 5); R = (st >> 1) * 16 + swz / 64; C = (st & 1) * 32 + (swz % 64) / 2; }
__host__ __device__ __forceinline__ int perm32(int rho) { const int n = rho >> 4, i = rho & 15; return 8 * (i >> 2) + 4 * n + (i & 3); }

struct Unit { int pm, pn; };
struct Gemm { const bf16_t* A; const bf16_t* Bt; int M, N, K; };

struct StaticOrder {
    int nM, nN, nwg, G, c;
    __host__ __device__ void init(int M, int N, int G_, int c_) { nM = M / BM; nN = N / BM; nwg = nM * nN; G = G_; c = c_; }
    __host__ __device__ bool next(int i, Unit& u) const {
        const long L = (long)i * G + c; if (L >= nwg) return false;
        int wgid = (int)L; { const int q = nwg / NXCD, r = nwg % NXCD, xcd = wgid % NXCD, off = wgid / NXCD; wgid = (xcd < r ? xcd * (q + 1) : r * (q + 1) + (xcd - r) * q) + off; }
        const int nig = WGM * nN, gid = wgid / nig, fm = gid * WGM, gsz = (nM - fm) < WGM ? (nM - fm) : WGM;
        u.pm = fm + ((wgid % nig) % gsz); u.pn = (wgid % nig) / gsz; return true;
    }
    __device__ __forceinline__ void a_ready(const Unit&) const {}
    __device__ __forceinline__ void done(const Unit&) const {}
};

__device__ __forceinline__ unsigned cvt_pk_bf16(float lo, float hi) { unsigned r; asm volatile("v_cvt_pk_bf16_f32 %0, %1, %2" : "=v"(r) : "v"(lo), "v"(hi)); return r; }
template <class Epi, class Sched, bool ALIGN_EPI = false, bool SP2 = false>
__device__ __forceinline__ void gemm_phase(PG8_LAS unsigned char* lds, const Gemm g, const Sched& S, const Epi& E) {
    const int tid = threadIdx.x, wid = __builtin_amdgcn_readfirstlane(tid >> 6), lane = tid & 63, wr = wid >> 2, wc = wid & 3, fr = lane & 15, fq = lane >> 4;
    const int K = g.K, nt = K / BK;
    unsigned voffA[2], voffB[2];
#pragma unroll
    for (int i = 0; i < 2; ++i) { int R, C; stage_rc(tid * 16 + i * 8192, R, C); const int Rb = Epi::PERM ? ((R & ~31) + perm32(R & 31)) : R;
        voffA[i] = (unsigned)(R * K + C) * 2u; voffB[i] = (unsigned)(Rb * K + C) * 2u; }
    const size_t kstep = (size_t)(BK * 2);
    const size_t hstep = (size_t)HALF * K * 2;
    const size_t tstep = 2 * hstep;
    const unsigned ldsw = (unsigned)wid * 1024u;
    const int aoff = lds_byte(wr * 64 + fr, fq * 8), boff = lds_byte(wc * 32 + fr, fq * 8);
#define PG8_SA(b, h) (((b) * 2 + (h)) * HTB)
#define PG8_SB(b, h) ((4 + (b) * 2 + (h)) * HTB)
#define PG8_STAGE(bufoff, gbase, voff) do { _Pragma("unroll") for (int _i = 0; _i < 2; ++_i) \
        __builtin_amdgcn_global_load_lds((const unsigned*)((const char*)(gbase) + (voff)[_i]), (PG8_LAS unsigned*)(lds + (bufoff) + ldsw + _i * 8192), 16, 0, 0); } while (0)
#define PG8_LDA(dst, b, h) do { _Pragma("unroll") for (int m = 0; m < 4; ++m) _Pragma("unroll") for (int k = 0; k < 2; ++k) dst[m][k] = *(const PG8_LAS bf16x8*)(lds + PG8_SA(b, h) + aoff + m * 2048 + k * 1024); } while (0)
#define PG8_LDB(dst, b, h) do { _Pragma("unroll") for (int n = 0; n < 2; ++n) _Pragma("unroll") for (int k = 0; k < 2; ++k) dst[n][k] = *(const PG8_LAS bf16x8*)(lds + PG8_SB(b, h) + boff + n * 2048 + k * 1024); } while (0)
#define PG8_MMA(ai, bj, At, Bt) do { __builtin_amdgcn_s_setprio(1); _Pragma("unroll") for (int m = 0; m < 4; ++m) _Pragma("unroll") for (int n = 0; n < 2; ++n) _Pragma("unroll") for (int k = 0; k < 2; ++k) \
        acc[ai][bj][m][n] = __builtin_amdgcn_mfma_f32_16x16x32_bf16(Bt[n][k], At[m][k], acc[ai][bj][m][n], 0, 0, 0); __builtin_amdgcn_s_setprio(0); } while (0)
#define PG8_WAIT_V(n) asm volatile("s_waitcnt vmcnt(" #n ")" ::: "memory")
#define PG8_WAIT_L(n) asm volatile("s_waitcnt lgkmcnt(" #n ")" ::: "memory")
#define PG8_BAR __builtin_amdgcn_s_barrier()
#define PG8_SCHED __builtin_amdgcn_sched_barrier(0)
    Unit cur, nxt; int ui = 0;
    if (!S.next(0, cur)) return;
    f32x4 acc[2][2][4][2];
#pragma unroll
    for (int a = 0; a < 2; ++a)
#pragma unroll
        for (int b = 0; b < 2; ++b)
#pragma unroll
            for (int m = 0; m < 4; ++m)
#pragma unroll
                for (int n = 0; n < 2; ++n) acc[a][b][m][n] = (f32x4){0.f, 0.f, 0.f, 0.f};
    bf16x8 At[4][2], B0[2][2], B1[2][2];
    const char* cA = (const char*)g.A + (size_t)cur.pm * tstep; const char* cB = (const char*)g.Bt + (size_t)cur.pn * tstep;
    S.a_ready(cur);
    if constexpr (SP2) {
        PG8_STAGE(PG8_SB(0, 0), cB, voffB); PG8_STAGE(PG8_SB(0, 1), cB + hstep, voffB); PG8_STAGE(PG8_SA(0, 0), cA, voffA); PG8_STAGE(PG8_SA(0, 1), cA + hstep, voffA);
        if (wr == 1) PG8_BAR;
        PG8_WAIT_V(2); PG8_BAR;
        PG8_STAGE(PG8_SB(1, 0), cB + kstep, voffB); PG8_STAGE(PG8_SA(1, 0), cA + kstep, voffA); PG8_STAGE(PG8_SB(1, 1), cB + hstep + kstep, voffB);
        PG8_WAIT_V(6); PG8_BAR;
    } else {
        PG8_STAGE(PG8_SB(0, 0), cB, voffB); PG8_STAGE(PG8_SA(0, 0), cA, voffA); PG8_STAGE(PG8_SB(0, 1), cB + hstep, voffB); PG8_STAGE(PG8_SA(0, 1), cA + hstep, voffA);
        if (wr == 1) PG8_BAR;
        PG8_WAIT_V(4); PG8_BAR;
        PG8_STAGE(PG8_SB(1, 0), cB + kstep, voffB); PG8_STAGE(PG8_SA(1, 0), cA + kstep, voffA); PG8_STAGE(PG8_SB(1, 1), cB + hstep + kstep, voffB);
        PG8_WAIT_V(6); PG8_BAR;
    }
    for (;;) {
        const bool has_next = S.next(ui + 1, nxt);
        const char* nA = has_next ? (const char*)g.A + (size_t)nxt.pm * tstep : cA; const char* nB = has_next ? (const char*)g.Bt + (size_t)nxt.pn * tstep : cB;
        for (int t = 0; t < nt; t += 2) {
            const bool last = (t == nt - 2);
            const char* a1 = cA + (size_t)(t + 1) * kstep;
            const char* a2 = last ? nA : cA + (size_t)(t + 2) * kstep; const char* b2 = last ? nB : cB + (size_t)(t + 2) * kstep;
            const char* a3 = a2 + kstep; const char* b3 = b2 + kstep;
            if (last && has_next) S.a_ready(nxt);
            if constexpr (SP2) {
            PG8_LDB(B0, 0, 0); PG8_LDB(B1, 0, 1); PG8_SCHED; PG8_LDA(At, 0, 0); PG8_STAGE(PG8_SA(1, 1), a1 + hstep, voffA);
            PG8_WAIT_V(8); PG8_WAIT_L(0); PG8_BAR; PG8_MMA(0, 0, At, B0); PG8_MMA(0, 1, At, B1); PG8_BAR; PG8_SCHED;
            PG8_LDA(At, 0, 1); PG8_STAGE(PG8_SB(0, 0), b2, voffB); PG8_STAGE(PG8_SB(0, 1), b2 + hstep, voffB); PG8_STAGE(PG8_SA(0, 0), a2, voffA);
            PG8_WAIT_V(8); PG8_WAIT_L(0); PG8_BAR; PG8_MMA(1, 0, At, B0); PG8_MMA(1, 1, At, B1); PG8_BAR; PG8_SCHED;
            PG8_LDB(B0, 1, 0); PG8_LDB(B1, 1, 1); PG8_SCHED; PG8_LDA(At, 1, 0); PG8_STAGE(PG8_SA(0, 1), a2 + hstep, voffA);
            PG8_WAIT_V(8); PG8_WAIT_L(0); PG8_BAR; PG8_MMA(0, 0, At, B0); PG8_MMA(0, 1, At, B1); PG8_BAR; PG8_SCHED;
            PG8_LDA(At, 1, 1); PG8_STAGE(PG8_SB(1, 0), b3, voffB); PG8_STAGE(PG8_SB(1, 1), b3 + hstep, voffB); PG8_STAGE(PG8_SA(1, 0), a3, voffA);
            PG8_WAIT_V(8); PG8_WAIT_L(0); PG8_BAR; PG8_MMA(1, 0, At, B0); PG8_MMA(1, 1, At, B1); PG8_BAR; PG8_SCHED;
            } else {
            PG8_LDB(B0, 0, 0); PG8_SCHED; PG8_LDA(At, 0, 0); PG8_STAGE(PG8_SA(1, 1), a1 + hstep, voffA);
            PG8_WAIT_L(8); PG8_BAR; PG8_WAIT_L(0); PG8_MMA(0, 0, At, B0); PG8_BAR; PG8_SCHED;
            PG8_LDB(B1, 0, 1); PG8_STAGE(PG8_SB(0, 0), b2, voffB);
            PG8_BAR; PG8_WAIT_L(0); PG8_MMA(0, 1, At, B1); PG8_BAR;
            PG8_LDA(At, 0, 1); PG8_STAGE(PG8_SA(0, 0), a2, voffA);
            PG8_BAR; PG8_WAIT_L(0); PG8_MMA(1, 0, At, B0); PG8_BAR; PG8_SCHED;
            PG8_STAGE(PG8_SB(0, 1), b2 + hstep, voffB);
            PG8_WAIT_V(6); PG8_BAR; PG8_MMA(1, 1, At, B1); PG8_BAR;
            PG8_LDB(B0, 1, 0); PG8_SCHED; PG8_LDA(At, 1, 0); PG8_STAGE(PG8_SA(0, 1), a2 + hstep, voffA);
            PG8_WAIT_L(8); PG8_BAR; PG8_WAIT_L(0); PG8_MMA(0, 0, At, B0); PG8_BAR; PG8_SCHED;
            PG8_LDB(B1, 1, 1); PG8_STAGE(PG8_SB(1, 0), b3, voffB);
            PG8_BAR; PG8_WAIT_L(0); PG8_MMA(0, 1, At, B1); PG8_BAR;
            PG8_LDA(At, 1, 1); PG8_STAGE(PG8_SA(1, 0), a3, voffA);
            PG8_BAR; PG8_WAIT_L(0); PG8_MMA(1, 0, At, B0); PG8_BAR; PG8_SCHED;
            PG8_STAGE(PG8_SB(1, 1), b3 + hstep, voffB);
            PG8_WAIT_V(6); PG8_BAR; PG8_MMA(1, 1, At, B1); PG8_BAR;
            }
        }
        if constexpr (ALIGN_EPI) { if (wr == 0) PG8_BAR; }
        if constexpr (!Epi::AFTER_DRAIN) { E(acc, cur, wr, wc, fr, fq); S.done(cur); }
        if (!has_next) break;
#pragma unroll
        for (int a = 0; a < 2; ++a)
#pragma unroll
            for (int b = 0; b < 2; ++b)
#pragma unroll
                for (int m = 0; m < 4; ++m)
#pragma unroll
                    for (int n = 0; n < 2; ++n) acc[a][b][m][n] = (f32x4){0.f, 0.f, 0.f, 0.f};
        cur = nxt; cA = nA; cB = nB; ++ui;
        if constexpr (ALIGN_EPI) { if (wr == 1) PG8_BAR; }
    }
    PG8_WAIT_V(0);
    if constexpr (!ALIGN_EPI) { if (wr == 0) PG8_BAR; }
    PG8_BAR;
    if constexpr (Epi::AFTER_DRAIN) { E.fused(acc, cur, wr, wc, fr, fq, lds, wid, lane); S.done(cur); }
#undef PG8_SA
#undef PG8_SB
#undef PG8_STAGE
#undef PG8_LDA
#undef PG8_LDB
#undef PG8_MMA
#undef PG8_WAIT_V
#undef PG8_WAIT_L
#undef PG8_BAR
#undef PG8_SCHED
}
}
namespace pg8 {
__device__ __forceinline__ float fast_sigmoid(float v) { return __builtin_amdgcn_rcpf(1.f + __expf(-v)); }
struct EpiInProj {
    static constexpr bool PERM = true, AFTER_DRAIN = false;
    unsigned char* ws; bf16_t* sg; const float* COS; const float* SIN;
    __device__ __forceinline__ void operator()(const f32x4 (&acc)[2][2][4][2], const Unit& u, int wr, int wc, int fr, int fq) const {
        const int pn = u.pn, row0 = u.pm * BM + wr * 64 + fr, cw = wc * 32 + 8 * fq;
#pragma unroll
        for (int ai = 0; ai < 2; ++ai)
#pragma unroll
            for (int m = 0; m < 4; ++m) {
                const int row = row0 + ai * HALF + m * 16, bb = row >> 12, pos = row & 4095, tile = pos >> 6, kvr = pos & 63;
                if (pn < 4) {
                    const int i0 = (cw & 63) >> 1;
                    const f32x4 cs = *(const f32x4*)(COS + pos * 32 + i0), sn = *(const f32x4*)(SIN + pos * 32 + i0);
#pragma unroll
                    for (int bj = 0; bj < 2; ++bj) {
                        const f32x4 v0 = acc[ai][bj][m][0], v1 = acc[ai][bj][m][1];
                        float o[8];
                        o[0] = v0[0] * cs[0] - v0[1] * sn[0]; o[1] = v0[1] * cs[0] + v0[0] * sn[0];
                        o[2] = v0[2] * cs[1] - v0[3] * sn[1]; o[3] = v0[3] * cs[1] + v0[2] * sn[1];
                        o[4] = v1[0] * cs[2] - v1[1] * sn[2]; o[5] = v1[1] * cs[2] + v1[0] * sn[2];
                        o[6] = v1[2] * cs[3] - v1[3] * sn[3]; o[7] = v1[3] * cs[3] + v1[2] * sn[3];
                        const int cq = (pn & 1) * 256 + bj * HALF + cw;
                        u32x4 w;
                        if (pn < 2) { w.x = cvt_pk_bf16(o[0] * C2, o[1] * C2); w.y = cvt_pk_bf16(o[2] * C2, o[3] * C2); w.z = cvt_pk_bf16(o[4] * C2, o[5] * C2); w.w = cvt_pk_bf16(o[6] * C2, o[7] * C2);
                            *(u32x4*)((bf16_t*)(ws + WS_Q) + (size_t)row * QKW + cq) = w; }
                        else { w.x = cvt_pk_bf16(o[0], o[1]); w.y = cvt_pk_bf16(o[2], o[3]); w.z = cvt_pk_bf16(o[4], o[5]); w.w = cvt_pk_bf16(o[6], o[7]);
                            const int g = cq >> 6; *(u32x4*)(ws + WS_KV + kv_tile_off(bb, g >> 1, tile) + k_img_off(g & 1, kvr, cq & 63)) = w; }
                    }
                } else {
#pragma unroll
                    for (int bj = 0; bj < 2; ++bj) {
                        f32x4 v0 = acc[ai][bj][m][0], v1 = acc[ai][bj][m][1];
                        if (pn >= 12) {
#pragma unroll
                            for (int q = 0; q < 4; ++q) { v0[q] = fast_sigmoid(v0[q]); v1[q] = fast_sigmoid(v1[q]); } }
                        u32x4 w; w.x = cvt_pk_bf16(v0[0], v0[1]); w.y = cvt_pk_bf16(v0[2], v0[3]); w.z = cvt_pk_bf16(v1[0], v1[1]); w.w = cvt_pk_bf16(v1[2], v1[3]);
                        if (pn < 6) { const int ce = (pn - 4) * 256 + bj * HALF + cw; *(u32x4*)(ws + WS_KV + kv_tile_off(bb, ce >> 7, tile) + v_img_off(kvr, ce & 127)) = w; }
                        else if (pn < 12) { const int jj = (pn - 6) * 256 + bj * HALF + cw, which = jj >> 9, cc = jj & 511;
                            *(u32x4*)((bf16_t*)(ws + (which == 0 ? WS_BG : which == 1 ? WS_CG : WS_XC)) + (size_t)row * CW + cc) = w; }
                        else { const int jj = (pn - 12) * 256 + bj * HALF + cw, which = jj >> 10, cc = jj & 1023;
                            *(u32x4*)(sg + (size_t)which * NTOK * DM + (size_t)row * DM + cc) = w; }
                    }
                }
            }
    }
};
template <int SECOND> struct EpiGate {
    static constexpr bool PERM = true, AFTER_DRAIN = false;
    const bf16_t* gate; const bf16_t* prev; bf16_t* O;
    __device__ __forceinline__ void operator()(const f32x4 (&acc)[2][2][4][2], const Unit& u, int wr, int wc, int fr, int fq) const {
        const int row0 = u.pm * BM + wr * 64 + fr, col0 = u.pn * BM + wc * 32 + 8 * fq;
#pragma unroll
        for (int ai = 0; ai < 2; ++ai)
#pragma unroll
            for (int m = 0; m < 4; ++m) {
                const size_t ro = (size_t)(row0 + ai * HALF + m * 16) * DM + col0;
#pragma unroll
                for (int bj = 0; bj < 2; ++bj) {
                    const f32x4 v0 = acc[ai][bj][m][0], v1 = acc[ai][bj][m][1];
                    const u32x4 g = *(const u32x4*)(gate + ro + bj * HALF);
                    float o[8];
                    o[0] = bflo(g.x) * v0[0]; o[1] = bfhi(g.x) * v0[1]; o[2] = bflo(g.y) * v0[2]; o[3] = bfhi(g.y) * v0[3];
                    o[4] = bflo(g.z) * v1[0]; o[5] = bfhi(g.z) * v1[1]; o[6] = bflo(g.w) * v1[2]; o[7] = bfhi(g.w) * v1[3];
                    if (SECOND) { const u32x4 p = *(const u32x4*)(prev + ro + bj * HALF);
                        o[0] += bflo(p.x); o[1] += bfhi(p.x); o[2] += bflo(p.y); o[3] += bfhi(p.y); o[4] += bflo(p.z); o[5] += bfhi(p.z); o[6] += bflo(p.w); o[7] += bfhi(p.w); }
                    u32x4 w; w.x = cvt_pk_bf16(o[0], o[1]); w.y = cvt_pk_bf16(o[2], o[3]); w.z = cvt_pk_bf16(o[4], o[5]); w.w = cvt_pk_bf16(o[6], o[7]);
                    *(u32x4*)(O + ro + bj * HALF) = w;
                }
            }
    }
};
struct EpiResid {
    static constexpr bool PERM = false, AFTER_DRAIN = false;
    const float* base; float* C;
    __device__ __forceinline__ void operator()(const f32x4 (&acc)[2][2][4][2], const Unit& u, int wr, int wc, int fr, int fq) const {
        const int row0 = u.pm * BM + wr * 64 + fr, col0 = u.pn * BM + wc * 32 + 4 * fq;
#pragma unroll
        for (int ai = 0; ai < 2; ++ai)
#pragma unroll
            for (int m = 0; m < 4; ++m) { const size_t ro = (size_t)(row0 + ai * HALF + m * 16) * DM + col0;
#pragma unroll
                for (int bj = 0; bj < 2; ++bj)
#pragma unroll
                    for (int n = 0; n < 2; ++n) *(f32x4*)(C + ro + bj * HALF + n * 16) = acc[ai][bj][m][n] + *(const f32x4*)(base + ro + bj * HALF + n * 16); }
    }
};
struct EpiPlainBf16 {
    static constexpr bool PERM = true, AFTER_DRAIN = false;
    bf16_t* O; int ldc;
    __device__ __forceinline__ void operator()(const f32x4 (&acc)[2][2][4][2], const Unit& u, int wr, int wc, int fr, int fq) const {
        const int row0 = u.pm * BM + wr * 64 + fr, col0 = u.pn * BM + wc * 32 + 8 * fq;
#pragma unroll
        for (int ai = 0; ai < 2; ++ai)
#pragma unroll
            for (int m = 0; m < 4; ++m) { bf16_t* rowp = O + (size_t)(row0 + ai * HALF + m * 16) * ldc + col0;
#pragma unroll
                for (int bj = 0; bj < 2; ++bj) { const f32x4 v0 = acc[ai][bj][m][0], v1 = acc[ai][bj][m][1];
                    u32x4 w; w.x = cvt_pk_bf16(v0[0], v0[1]); w.y = cvt_pk_bf16(v0[2], v0[3]); w.z = cvt_pk_bf16(v1[0], v1[1]); w.w = cvt_pk_bf16(v1[2], v1[3]);
                    *(u32x4*)(rowp + bj * HALF) = w; } }
    }
};
}

constexpr int NWAVES = 8;
constexpr int RING_BYTES = 131072, LDSCTL_OFF = RING_BYTES, MISC_OFF = LDSCTL_OFF + 320, LDS_BYTES = 147456;
constexpr int CW_BAR = 4096;
#define RLX_AGENT __ATOMIC_RELAXED, __HIP_MEMORY_SCOPE_AGENT
#define XB_TMO      128
#define XB_XCNT(j)  (256  + 64 * (j))
#define XB_XSUB(j)  (1280 + 64 * (j))
#define XB_XGEN(j)  (2304 + 64 * (j))
#define XB_TOP      3328
#define XB_TOPGEN   3392
#define XCD_BAR_WORDS 3456
#define XB_SPIN_CAP (1u << 18)

__device__ __forceinline__ unsigned xb_ld(unsigned* p)              { return __hip_atomic_load(p, __ATOMIC_RELAXED, __HIP_MEMORY_SCOPE_AGENT); }
__device__ __forceinline__ unsigned xb_add(unsigned* p, unsigned v) { return __hip_atomic_fetch_add(p, v, __ATOMIC_RELAXED, __HIP_MEMORY_SCOPE_AGENT); }
__device__ __forceinline__ unsigned xb_xcc_id() { return (unsigned)__builtin_amdgcn_s_getreg((3 << 11) | 20) & 0xFu; }
#define XB_SPIN(cond, bar) do { unsigned _sp = 0; while (cond) { __builtin_amdgcn_s_sleep(1); \
    if ((++_sp & 255u) == 0u) { if (xb_ld(&(bar)[XB_TMO])) break; if (_sp > XB_SPIN_CAP) { atomicAdd(&(bar)[XB_TMO], 1u); break; } } } } while (0)

struct XcdBarrier {
    unsigned* bar; unsigned x;
    volatile LAS unsigned* st;
};

__device__ __forceinline__ XcdBarrier xcd_barrier_post(unsigned* bar, volatile LAS unsigned* st) {
    XcdBarrier b; b.bar = bar; b.x = xb_xcc_id(); b.st = st;
    if (threadIdx.x == 0) (void)xb_add(&bar[XB_XCNT(b.x)], 1u);
    return b;
}
__device__ __forceinline__ void xcd_barrier_complete(unsigned* bar, unsigned x, unsigned& nloc, unsigned& nx) {
    const unsigned G = gridDim.x * gridDim.y * gridDim.z;
    unsigned sum, cnt, mine, sp = 0u;
    for (;;) {
        sum = 0u; cnt = 0u; mine = 0u;
#pragma unroll
        for (unsigned j = 0; j < 16; ++j) { const unsigned c = xb_ld(&bar[XB_XCNT(j)]); sum += c; cnt += (c > 0u) ? 1u : 0u; mine = (j == x) ? c : mine; }
        if (sum == G) break;
        __builtin_amdgcn_s_sleep(1);
        if ((++sp & 255u) == 0u) { if (xb_ld(&bar[XB_TMO])) break; if (sp > XB_SPIN_CAP) { atomicAdd(&bar[XB_TMO], 1u); break; } }
    }
    nloc = mine > 0u ? mine : 1u; nx = cnt > 0u ? cnt : 1u;
}

__device__ __forceinline__ void xcd_barrier(const XcdBarrier& b) {
    asm volatile("s_waitcnt vmcnt(0)" ::: "memory");
    __syncthreads();
    if (threadIdx.x == 0) {
        unsigned* bar = b.bar;
        __builtin_amdgcn_s_waitcnt(0);
        unsigned nloc = b.st[0], nx = b.st[1];
        if (nloc == 0u) { xcd_barrier_complete(bar, b.x, nloc, nx); b.st[0] = nloc; b.st[1] = nx; }
        const unsigned old = xb_add(&bar[XB_XSUB(b.x)], 1u);
        const unsigned gen = old / nloc;
        if (old + 1u == (gen + 1u) * nloc) {
            __builtin_amdgcn_fence(__ATOMIC_RELEASE, "agent");
            asm volatile("s_waitcnt vmcnt(0)" ::: "memory");
            const unsigned og = xb_add(&bar[XB_TOP], 1u);
            const unsigned tg = og / nx;
            if (og + 1u == (tg + 1u) * nx) xb_add(&bar[XB_TOPGEN], 1u);
            else XB_SPIN(xb_ld(&bar[XB_TOPGEN]) == tg, bar);
            __builtin_amdgcn_fence(__ATOMIC_ACQUIRE, "agent");
            xb_add(&bar[XB_XGEN(b.x)], 1u);
            asm volatile("s_waitcnt vmcnt(0)" ::: "memory");
        } else {
            XB_SPIN(xb_ld(&bar[XB_XGEN(b.x)]) == gen, bar);
            __builtin_amdgcn_fence(__ATOMIC_ACQUIRE, "agent");
            asm volatile("s_waitcnt vmcnt(0)" ::: "memory");
        }
    }
    __syncthreads();
}
namespace att {
typedef short v4i16_t __attribute__((ext_vector_type(4)));
constexpr int KVBUF = 32768, QF_OFF = 2 * KVBUF, WSF_OFF = 131072 + 1024, OST_OFF = 0;
constexpr float THR = 8.0f;
__device__ __forceinline__ int crow(int r, int hi) { return (r & 3) + 8 * (r >> 2) + 4 * hi; }
__device__ __forceinline__ float max3f(float a, float b, float c) { return __builtin_fmaxf(__builtin_fmaxf(a, b), c); }
__device__ __forceinline__ float max2f(float a, float b) { return __builtin_fmaxf(a, b); }
__device__ __forceinline__ float halves_max(float v) { auto rr = __builtin_amdgcn_permlane32_swap(__float_as_uint(v), __float_as_uint(v), false, false); return max2f(__uint_as_float(rr[0]), __uint_as_float(rr[1])); }
__device__ __forceinline__ float halves_sum(float v) { auto rr = __builtin_amdgcn_permlane32_swap(__float_as_uint(v), __float_as_uint(v), false, false); return __uint_as_float(rr[0]) + __uint_as_float(rr[1]); }
__device__ __forceinline__ unsigned cvtpk(float lo, float hi) { typedef float f2 __attribute__((ext_vector_type(2))); typedef __bf16 b2 __attribute__((ext_vector_type(2))); f2 v = {lo, hi}; b2 b = __builtin_convertvector(v, b2); return __builtin_bit_cast(unsigned, b); }

__device__ __forceinline__ void attn_unit(const Ptrs& P, LAS unsigned char* L, int b, int h, int qb, float lam, int wave, int lane) {
    int r32 = lane & 31, hi = lane >> 5;
    const unsigned char* kvbase = P.ws + WS_KV + kv_tile_off(b, h, 0);
    LAS float* wsf = (LAS float*)(L + WSF_OFF) + wave * 64;
#define ATT_DMA(t, bufoff) do { _Pragma("unroll") for (int j_ = 0; j_ < 4; ++j_) { const int piece_ = wave * 4 + j_; \
        __builtin_amdgcn_global_load_lds((const unsigned*)(kvbase + (size_t)(t) * 32768 + piece_ * 1024 + lane * 16), (LAS unsigned*)(L + (bufoff) + piece_ * 1024), 16, 0, 0); } } while (0)
    ATT_DMA(0, 0);
    LAS unsigned char* qfl = L + QF_OFF + wave * 8192 + lane * 16;
    { const bf16* Qw = (const bf16*)(P.ws + WS_Q) + (size_t)(b * SEQ + qb * 256 + wave * 32 + r32) * QKW + h * 128 + hi * 8;
#pragma unroll
      for (int m = 0; m < 2; ++m)
#pragma unroll
          for (int d0 = 0; d0 < 4; ++d0) *(LAS bf16x8*)(qfl + (m * 4 + d0) * 1024) = *(const bf16x8*)(Qw + m * 64 + d0 * 16); }
    f32x16 o[2][4];
#pragma unroll
    for (int m = 0; m < 2; ++m)
#pragma unroll
        for (int k = 0; k < 4; ++k) o[m][k] = f32x16{};
    float mhat[2] = {-1e30f, -1e30f}, lsum[2] = {0.f, 0.f};
    const int vlane = 16384 + ((lane >> 4) & 1) * 32 + (lane & 3) * 8 + (4 * hi + ((lane & 15) >> 2)) * 64;
    asm volatile("s_waitcnt vmcnt(0)" ::: "memory"); __syncthreads();
    for (int t = 0; t < 64; ++t) {
        const int cur = (t & 1) * KVBUF;
        if (t + 1 < 64) ATT_DMA(t + 1, KVBUF - cur);
        bf16x8 pa[2][4];
#pragma unroll
        for (int m = 0; m < 2; ++m) {
            f32x16 p0 = f32x16{}, p1 = f32x16{};
            const LAS unsigned char* kb = L + cur + m * 8192 + hi * 1024 + r32 * 16;
#pragma unroll
            for (int d0 = 0; d0 < 4; ++d0) {
                const bf16x8 k0 = *(const LAS bf16x8*)(kb + d0 * 2048), k1 = *(const LAS bf16x8*)(kb + d0 * 2048 + 512);
                const bf16x8 q = *(const LAS bf16x8*)(qfl + (m * 4 + d0) * 1024);
                p0 = __builtin_amdgcn_mfma_f32_32x32x16_bf16(k0, q, p0, 0, 0, 0);
                p1 = __builtin_amdgcn_mfma_f32_32x32x16_bf16(k1, q, p1, 0, 0, 0);
            }
            float rm = max3f(p0[0], p1[0], p0[1]), rm2 = max3f(p1[1], p0[2], p1[2]);
#pragma unroll
            for (int r = 3; r < 15; r += 2) { rm = max3f(rm, p0[r], p1[r]); rm2 = max3f(rm2, p0[r + 1], p1[r + 1]); }
            rm = max3f(rm, p0[15], p1[15]);
            rm = halves_max(max2f(rm, rm2));
            if (__any(rm > mhat[m] + THR)) {
                const float mn = max2f(mhat[m], rm), f = __builtin_amdgcn_exp2f(mhat[m] - mn);
                mhat[m] = mn; lsum[m] *= f;
                if (hi == 0) wsf[r32] = f;
                asm volatile("s_waitcnt lgkmcnt(0)" ::: "memory");
#pragma unroll
                for (int r = 0; r < 16; ++r) { const float fr = wsf[crow(r, hi)];
#pragma unroll
                    for (int k = 0; k < 4; ++k) o[m][k][r] *= fr; }
                asm volatile("s_waitcnt lgkmcnt(0)" ::: "memory");
            }
            const float mh = mhat[m]; float ls = 0.f;
#pragma unroll
            for (int r = 0; r < 16; ++r) { p0[r] = __builtin_amdgcn_exp2f(p0[r] - mh); p1[r] = __builtin_amdgcn_exp2f(p1[r] - mh); ls += p0[r] + p1[r]; }
            lsum[m] += ls;
            { u32x4 w;
              w.x = cvtpk(p0[0], p0[1]); w.y = cvtpk(p0[2], p0[3]); w.z = cvtpk(p0[4], p0[5]); w.w = cvtpk(p0[6], p0[7]); pa[m][0] = __builtin_bit_cast(bf16x8, w);
              w.x = cvtpk(p0[8], p0[9]); w.y = cvtpk(p0[10], p0[11]); w.z = cvtpk(p0[12], p0[13]); w.w = cvtpk(p0[14], p0[15]); pa[m][1] = __builtin_bit_cast(bf16x8, w);
              w.x = cvtpk(p1[0], p1[1]); w.y = cvtpk(p1[2], p1[3]); w.z = cvtpk(p1[4], p1[5]); w.w = cvtpk(p1[6], p1[7]); pa[m][2] = __builtin_bit_cast(bf16x8, w);
              w.x = cvtpk(p1[8], p1[9]); w.y = cvtpk(p1[10], p1[11]); w.z = cvtpk(p1[12], p1[13]); w.w = cvtpk(p1[14], p1[15]); pa[m][3] = __builtin_bit_cast(bf16x8, w); }
        }
        { const LAS unsigned char* vb = L + cur + vlane;
#pragma unroll
          for (int blk = 0; blk < 4; ++blk)
#pragma unroll
              for (int ks = 0; ks < 4; ++ks) {
                  const v4i16_t lo = __builtin_amdgcn_ds_read_tr16_b64_v4i16((LAS v4i16_t*)(vb + blk * 4096 + ks * 1024));
                  const v4i16_t hv = __builtin_amdgcn_ds_read_tr16_b64_v4i16((LAS v4i16_t*)(vb + blk * 4096 + ks * 1024 + 512));
                  const bf16x8 vf = (bf16x8){lo[0], lo[1], lo[2], lo[3], hv[0], hv[1], hv[2], hv[3]};
                  o[0][blk] = __builtin_amdgcn_mfma_f32_32x32x16_bf16(pa[0][ks], vf, o[0][blk], 0, 0, 0);
                  o[1][blk] = __builtin_amdgcn_mfma_f32_32x32x16_bf16(pa[1][ks], vf, o[1][blk], 0, 0, 0);
              } }
        asm volatile("s_waitcnt vmcnt(0) lgkmcnt(0)" ::: "memory"); __syncthreads();
    }
#undef ATT_DMA
    asm volatile("" : "+v"(lane));
    r32 = lane & 31; hi = lane >> 5;
    const float l0 = halves_sum(lsum[0]), l1 = halves_sum(lsum[1]);
    if (hi == 0) { wsf[r32] = 1.f / l0; wsf[32 + r32] = lam / l1; }
    asm volatile("s_waitcnt lgkmcnt(0)" ::: "memory");
    float ss[16];
#pragma unroll
    for (int r = 0; r < 16; ++r) { const float a = wsf[crow(r, hi)], c = wsf[32 + crow(r, hi)]; float s = 0.f;
#pragma unroll
        for (int k = 0; k < 4; ++k) { const float d = o[0][k][r] * a - o[1][k][r] * c; o[0][k][r] = d; s += d * d; }
        ss[r] = s; }
#pragma unroll
    for (int r = 0; r < 16; ++r) {
#pragma unroll
        for (int x = 1; x < 32; x <<= 1) ss[r] += __shfl_xor(ss[r], x);
        ss[r] = rsqrtf(ss[r] * (1.f / DV) + EPS) * (1.f - LAMBDA_INIT); }
    LAS bf16* stg = (LAS bf16*)(L + OST_OFF) + wave * 4096;
#pragma unroll
    for (int k = 0; k < 4; ++k) { const float sw = P.subln_w[k * 32 + r32];
#pragma unroll
        for (int r = 0; r < 16; ++r) stg[crow(r, hi) * 128 + k * 32 + r32] = (bf16)f2bf(o[0][k][r] * ss[r] * sw); }
    asm volatile("s_waitcnt lgkmcnt(0)" ::: "memory");
    bf16* AT = (bf16*)(P.ws + WS_ATTN) + (size_t)(b * SEQ + qb * 256 + wave * 32) * AW + h * DV;
#pragma unroll
    for (int i = 0; i < 8; ++i) { const int row = i * 4 + (lane >> 4), ch = lane & 15;
        const u32x4 v = *(const LAS u32x4*)(stg + row * 128 + ch * 8); *(u32x4*)(AT + (size_t)row * AW + ch * 8) = v; }
    asm volatile("s_waitcnt lgkmcnt(0)" ::: "memory"); __syncthreads();
}
__device__ __forceinline__ void attn_phase(const Ptrs& P, LAS unsigned char* L, int vcu, int G, int wave, int lane) {
    const float lam = lam_value(P);
    for (int u = vcu; u < NB * NH * 16; u += G) attn_unit(P, L, u >> 6, (u >> 4) & 3, u & 15, lam, wave, lane);
}
}
namespace tk {
constexpr int KEYS_LDS = 0, IDX_LDS = 65536;
__device__ __forceinline__ unsigned umax(unsigned a, unsigned b) { return a > b ? a : b; }
__device__ __forceinline__ unsigned umin(unsigned a, unsigned b) { return a < b ? a : b; }
__device__ __forceinline__ unsigned f2sort(float f) { const unsigned u = __float_as_uint(f); return u ^ ((unsigned)((int)u >> 31) | 0x80000000u); }
__device__ __forceinline__ float sort2f(unsigned s) { const unsigned u = (s & 0x80000000u) ? (s ^ 0x80000000u) : ~s; return __uint_as_float(u); }
__device__ __forceinline__ unsigned partner32(unsigned v, int hi) { auto rr = __builtin_amdgcn_permlane32_swap(v, v, false, false); return hi ? rr[0] : rr[1]; }
__device__ __forceinline__ void sort16_desc(unsigned* x) {
#pragma unroll
    for (int k = 2; k <= 16; k <<= 1)
#pragma unroll
        for (int j = k >> 1; j > 0; j >>= 1)
#pragma unroll
            for (int i = 0; i < 16; ++i) { const int l = i ^ j; if (l > i) { const bool desc = ((i & k) == 0); const unsigned mx = umax(x[i], x[l]), mn = umin(x[i], x[l]); x[i] = desc ? mx : mn; x[l] = desc ? mn : mx; } }
}
__device__ __forceinline__ void merge16_desc(unsigned* a, const unsigned* b) {
#pragma unroll
    for (int i = 0; i < 16; ++i) a[i] = umax(a[i], b[15 - i]);
#pragma unroll
    for (int j = 8; j > 0; j >>= 1)
#pragma unroll
        for (int i = 0; i < 16; ++i) { const int l = i ^ j; if (l > i) { const unsigned mx = umax(a[i], a[l]), mn = umin(a[i], a[l]); a[i] = mx; a[l] = mn; } }
}
__device__ __forceinline__ void merge_partner(unsigned* a, int hi) {
    unsigned b[16];
#pragma unroll
    for (int i = 0; i < 16; ++i) b[i] = partner32(a[i], hi);
    merge16_desc(a, b);
}
__device__ __forceinline__ void topk_unit(const Ptrs& P, LAS unsigned char* L, int tb, int hd, int wave, int lane, int tid) {
    const int r32 = lane & 31, hi = lane >> 5;
    const int tok = tb * 256 + wave * 32 + r32;
    const bf16* QPr = (const bf16*)(P.ws + WS_QP) + (size_t)tok * QPW + hd * 256 + hi * 8;
    unsigned S[2][16];
#pragma unroll
    for (int p = 0; p < 2; ++p) {
        bf16x8 qf[8];
#pragma unroll
        for (int d0 = 0; d0 < 8; ++d0) qf[d0] = *(const bf16x8*)(QPr + p * 128 + d0 * 16);
        unsigned x[64];
#pragma unroll
        for (int kb = 0; kb < 4; ++kb) {
            f32x16 acc = f32x16{};
            const LAS unsigned char* ka = L + KEYS_LDS + p * 32768 + hi * 2048 + (kb * 32 + r32) * 16;
#pragma unroll
            for (int d0 = 0; d0 < 8; ++d0) acc = __builtin_amdgcn_mfma_f32_32x32x16_bf16(*(const LAS bf16x8*)(ka + d0 * 4096), qf[d0], acc, 0, 0, 0);
#pragma unroll
            for (int r = 0; r < 16; ++r) x[kb * 16 + r] = (f2sort(acc[r]) & ~127u) | (unsigned)(kb * 32 + (r & 3) + 8 * (r >> 2) + 4 * hi);
        }
        sort16_desc(x); sort16_desc(x + 16); sort16_desc(x + 32); sort16_desc(x + 48);
        merge16_desc(x, x + 16); merge16_desc(x + 32, x + 48); merge16_desc(x, x + 32);
        merge_partner(x, hi);
#pragma unroll
        for (int i = 0; i < 16; ++i) S[p][i] = x[i];
    }
    LAS unsigned char* ib = L + IDX_LDS + tid * 32;
#pragma unroll
    for (int p = 0; p < 2; ++p) {
        u32x4 w;
        w.x = (S[p][0] & 127u) | ((S[p][1] & 127u) << 8) | ((S[p][2] & 127u) << 16) | ((S[p][3] & 127u) << 24);
        w.y = (S[p][4] & 127u) | ((S[p][5] & 127u) << 8) | ((S[p][6] & 127u) << 16) | ((S[p][7] & 127u) << 24);
        w.z = (S[p][8] & 127u) | ((S[p][9] & 127u) << 8) | ((S[p][10] & 127u) << 16) | ((S[p][11] & 127u) << 24);
        w.w = (S[p][12] & 127u) | ((S[p][13] & 127u) << 8) | ((S[p][14] & 127u) << 16) | ((S[p][15] & 127u) << 24);
        *(LAS u32x4*)(ib + p * 16) = w;
    }
    float va[16], vb[16];
#pragma unroll
    for (int i = 0; i < 16; ++i) { const float v0 = sort2f(S[0][i] & ~127u), v1 = sort2f(S[1][i] & ~127u); va[i] = hi ? v1 : v0; vb[i] = hi ? v0 : v1; }
    unsigned c[32];
    { int n = 0;
#pragma unroll
      for (int i = 0; i < 16; ++i)
#pragma unroll
          for (int j = i; j < 16; ++j) if ((i + 1) * (j + 1) <= 16) {
              const unsigned code = hi ? (unsigned)(j * 16 + i) : (unsigned)(i * 16 + j);
              unsigned v = (f2sort(va[i] + vb[j]) & ~255u) | code;
              if (i == j) v = hi ? 0u : v;
              c[n] = v; ++n; }
#pragma unroll
      for (; n < 32; ++n) c[n] = 0u; }
    sort16_desc(c); sort16_desc(c + 16); merge16_desc(c, c + 16);
    merge_partner(c, hi);
    const float tmax = sort2f(c[0] & ~255u); const unsigned hmask = (unsigned)(-hi);
    float e[8]; unsigned cd[8]; float es = 0.f;
#pragma unroll
    for (int k = 0; k < 8; ++k) { const unsigned v = (c[k + 8] & hmask) | (c[k] & ~hmask); cd[k] = v & 255u; e[k] = __expf(sort2f(v & ~255u) - tmax); es += e[k]; }
    const float rs = 1.f / att::halves_sum(es);
    asm volatile("s_waitcnt lgkmcnt(0)" ::: "memory");
    unsigned o[8];
#pragma unroll
    for (int k = 0; k < 8; ++k) { const unsigned i1 = ib[cd[k] >> 4], i2 = ib[16 + (cd[k] & 15u)]; o[k] = ((i1 * 128u + i2) << 16) | f2h(e[k] * rs); }
    unsigned* SEL = (unsigned*)(P.ws + WS_SEL) + (size_t)tok * 128 + hd * 16 + hi * 8;
    *(u32x4*)SEL = (u32x4){o[0], o[1], o[2], o[3]}; *(u32x4*)(SEL + 4) = (u32x4){o[4], o[5], o[6], o[7]};
}
__device__ __forceinline__ void topk_phase(const Ptrs& P, LAS unsigned char* L, int vcu, int G, int wave, int lane, int tid) {
    const int hd = vcu & 7;
    { const int key = tid & 127, p = (tid >> 7) & 1, cg = tid >> 8;
      const bf16* src = (const bf16*)(P.ws + WS_KEYS) + ((size_t)(hd * 2 + p) * NKEY + key) * PHD + cg * 64;
      u32x4 v[8];
#pragma unroll
      for (int i = 0; i < 8; ++i) v[i] = *(const u32x4*)(src + i * 8);
#pragma unroll
      for (int i = 0; i < 8; ++i) *(LAS u32x4*)(L + KEYS_LDS + p * 32768 + (cg * 8 + i) * 2048 + key * 16) = v[i]; }
    asm volatile("s_waitcnt lgkmcnt(0)" ::: "memory"); __syncthreads();
    for (int tb = vcu >> 3; tb < NTOK / 256; tb += (G >> 3)) topk_unit(P, L, tb, hd, wave, lane, tid);
    asm volatile("s_waitcnt lgkmcnt(0)" ::: "memory"); __syncthreads();
}
}
namespace pe {
constexpr int CHUNK = 16, NCHUNK = NTOK / CHUNK;
constexpr int CW_Q8A = 1024, CW_Q8B = 1024 + 8 * 64;
constexpr size_t WS_AP = WS_QP;
constexpr size_t WS_W = 54 * MiB;
constexpr size_t WS_SS = 62 * MiB;
__device__ __forceinline__ f32x2 fp8lo(unsigned w) { return __builtin_amdgcn_cvt_pk_f32_fp8((int)w, false); }
__device__ __forceinline__ f32x2 fp8hi(unsigned w) { return __builtin_amdgcn_cvt_pk_f32_fp8((int)w, true); }
__device__ __forceinline__ float dot16(const u32x4& u, const f32x2* h) {
    f32x2 a = fp8lo(u.x) * h[0]; a += fp8hi(u.x) * h[1]; a += fp8lo(u.y) * h[2]; a += fp8hi(u.y) * h[3];
    a += fp8lo(u.z) * h[4]; a += fp8hi(u.z) * h[5]; a += fp8lo(u.w) * h[6]; a += fp8hi(u.w) * h[7];
    return a.x + a.y;
}
__device__ __forceinline__ void axpy16(float w, const u32x4& v, f32x2* o) {
    const f32x2 ww = {w, w};
    o[0] += ww * fp8lo(v.x); o[1] += ww * fp8hi(v.x); o[2] += ww * fp8lo(v.y); o[3] += ww * fp8hi(v.y);
    o[4] += ww * fp8lo(v.z); o[5] += ww * fp8hi(v.z); o[6] += ww * fp8lo(v.w); o[7] += ww * fp8hi(v.w);
}
template <int X> __device__ __forceinline__ void reduce16_over8(const float* v, int lane, float* r) {
    float a[8], b[4];
    { const bool t = lane & X;
#pragma unroll
      for (int i = 0; i < 8; ++i) { const float keep = t ? v[2 * i + 1] : v[2 * i], send = t ? v[2 * i] : v[2 * i + 1]; a[i] = keep + __shfl_xor(send, X); } }
    { const bool t = lane & (2 * X);
#pragma unroll
      for (int i = 0; i < 4; ++i) { const float keep = t ? a[2 * i + 1] : a[2 * i], send = t ? a[2 * i] : a[2 * i + 1]; b[i] = keep + __shfl_xor(send, 2 * X); } }
    { const bool t = lane & (4 * X);
#pragma unroll
      for (int i = 0; i < 2; ++i) { const float keep = t ? b[2 * i + 1] : b[2 * i], send = t ? b[2 * i] : b[2 * i + 1]; r[i] = keep + __shfl_xor(send, 4 * X); } }
}
__device__ __forceinline__ int grab(unsigned* head, int lane) {
    unsigned c = 0; if (lane == 0) c = __hip_atomic_fetch_add(head, 1u, __ATOMIC_RELAXED, __HIP_MEMORY_SCOPE_AGENT);
    return (int)__builtin_amdgcn_readfirstlane(c);
}
struct SelBuf { u32x4 a, b, c, d; };
__device__ __forceinline__ void load_sel(SelBuf& S, const Ptrs& P, int t, int q) { const u32x4* sp = (const u32x4*)((const unsigned*)(P.ws + WS_SEL) + (size_t)t * 128 + q * 16); S.a = sp[0]; S.b = sp[1]; S.c = sp[2]; S.d = sp[3]; }
#define PE_SEL(S, it) ((it) < 4 ? S.a[(it) & 3] : (it) < 8 ? S.b[(it) & 3] : (it) < 12 ? S.c[(it) & 3] : S.d[(it) & 3])
#define PE_ROWS(R, S, base, loff) do { _Pragma("unroll") for (int it_ = 0; it_ < 16; ++it_) R[it_] = *(const u32x4*)((base) + (unsigned)(((PE_SEL(S, it_) >> 16) << 10) + (loff))); } while (0)
__device__ __forceinline__ void u_compute(const Ptrs& P, const u32x4* u, const u32x4& hA, const u32x4& hB, int t, int s, int lane) {
    const int q = lane >> 3, c = lane & 7;
    f32x2 h[8];
    h[0] = (f32x2){bflo(hA.x), bfhi(hA.x)}; h[1] = (f32x2){bflo(hA.y), bfhi(hA.y)}; h[2] = (f32x2){bflo(hA.z), bfhi(hA.z)}; h[3] = (f32x2){bflo(hA.w), bfhi(hA.w)};
    h[4] = (f32x2){bflo(hB.x), bfhi(hB.x)}; h[5] = (f32x2){bflo(hB.y), bfhi(hB.y)}; h[6] = (f32x2){bflo(hB.z), bfhi(hB.z)}; h[7] = (f32x2){bflo(hB.w), bfhi(hB.w)};
    float part[16];
#pragma unroll
    for (int it = 0; it < 16; ++it) part[it] = dot16(u[it], h);
    float r[2]; reduce16_over8<1>(part, lane, r);
    float* AP = (float*)(P.ws + WS_AP) + ((size_t)t * 8 + s) * 128 + q * 16 + c;
    AP[0] = r[0]; AP[8] = r[1];
}
__device__ __forceinline__ void u_chunk(const Ptrs& P, int t0, int s, int lane) {
    const int q = lane >> 3, c = lane & 7;
    const unsigned char* EU = P.ws + WS_EU; const unsigned eoff = (unsigned)(s * 128 + c * 16);
    const unsigned char* HNs = P.ws + WS_HN + s * 256 + c * 32;
    SelBuf S0, S1; u32x4 R0[16], R1[16], hA0, hB0, hA1, hB1;
    load_sel(S0, P, t0, q); load_sel(S1, P, t0 + 1, q);
    PE_ROWS(R0, S0, EU, eoff); hA0 = *(const u32x4*)(HNs + (size_t)t0 * (DM * 2)); hB0 = *(const u32x4*)(HNs + (size_t)t0 * (DM * 2) + 16);
#pragma unroll 1
    for (int i = 0; i < CHUNK; i += 2) {
        const int t = t0 + i;
        PE_ROWS(R1, S1, EU, eoff); hA1 = *(const u32x4*)(HNs + (size_t)(t + 1) * (DM * 2)); hB1 = *(const u32x4*)(HNs + (size_t)(t + 1) * (DM * 2) + 16);
        if (i + 2 < CHUNK) load_sel(S0, P, t + 2, q);
        u_compute(P, R0, hA0, hB0, t, s, lane);
        if (i + 2 < CHUNK) { PE_ROWS(R0, S0, EU, eoff); hA0 = *(const u32x4*)(HNs + (size_t)(t + 2) * (DM * 2)); hB0 = *(const u32x4*)(HNs + (size_t)(t + 2) * (DM * 2) + 16); }
        if (i + 3 < CHUNK) load_sel(S1, P, t + 3, q);
        u_compute(P, R1, hA1, hB1, t + 1, s, lane);
    }
}
__device__ __forceinline__ void phase_a(const Ptrs& P, unsigned* ctl, int xcc, int lane, int qoff = 0) {
    for (int si = 0; si < 8; ++si) { const int s = (xcc + si) & 7;
        for (;;) { const int ch = grab(ctl + CW_Q8A + qoff + 64 * s, lane); if (ch >= NCHUNK) break; u_chunk(P, ch * CHUNK, s, lane); } }
}
__device__ __forceinline__ void phase_a2(const Ptrs& P, int gtid, int nthreads) {
    const float* AP = (const float*)(P.ws + WS_AP); const unsigned* SEL = (const unsigned*)(P.ws + WS_SEL); const float* SC = (const float*)(P.ws + WS_SCU); float* W = (float*)(P.ws + WS_W);
    for (int i = gtid; i < NTOK * 128; i += nthreads) { const int t = i >> 7, k = i & 127; const float* ap = AP + (size_t)t * 1024 + k;
        float a = ((ap[0] + ap[128]) + (ap[256] + ap[384])) + ((ap[512] + ap[640]) + (ap[768] + ap[896]));
        const unsigned e = SEL[i]; a *= SC[e >> 16];
        W[i] = h2f(e) * (0.5f * a * (1.f + erff(a * 0.70710678118654752f))) * SC[NEXP + (e >> 16)]; }
}
__device__ __forceinline__ void v_compute(const Ptrs& P, const u32x4* v, const f32x4& w0, const f32x4& w1, const f32x4& w2, const f32x4& w3, float hv0, float hv1, int t, int s, int lane) {
    const int q = lane >> 3, c = lane & 7;
    const float w[16] = {w0.x, w0.y, w0.z, w0.w, w1.x, w1.y, w1.z, w1.w, w2.x, w2.y, w2.z, w2.w, w3.x, w3.y, w3.z, w3.w};
    f32x2 acc2[8];
#pragma unroll
    for (int i = 0; i < 8; ++i) acc2[i] = (f32x2){0.f, 0.f};
#pragma unroll
    for (int it = 0; it < 16; ++it) axpy16(w[it], v[it], acc2);
    float acc[16];
#pragma unroll
    for (int i = 0; i < 8; ++i) { acc[2 * i] = acc2[i].x; acc[2 * i + 1] = acc2[i].y; }
    float r[2]; reduce16_over8<8>(acc, lane, r);
    const int d0 = t * DM + s * 128 + c * 16 + q;
    const float y0 = hv0 + r[0], y1 = hv1 + r[1];
    P.out[d0] = y0; P.out[d0 + 8] = y1;
    const float ss = wave_sum(y0 * y0 + y1 * y1);
    if (lane == 0) ((float*)(P.ws + WS_SS))[t * 8 + s] = ss;
}
#define PE_VMETA(w0, w1, w2, w3, h0, h1, t_) do { const f32x4* wp_ = (const f32x4*)((const float*)(P.ws + WS_W) + (size_t)(t_) * 128 + q * 16); w0 = wp_[0]; w1 = wp_[1]; w2 = wp_[2]; w3 = wp_[3]; \
        const float* hp_ = (const float*)(P.ws + WS_H) + (size_t)(t_) * DM + s * 128 + c * 16 + q; h0 = hp_[0]; h1 = hp_[8]; } while (0)
__device__ __forceinline__ void v_chunk(const Ptrs& P, int t0, int s, int lane) {
    const int q = lane >> 3, c = lane & 7;
    const unsigned char* EV = P.ws + WS_EV; const unsigned eoff = (unsigned)(s * 128 + c * 16);
    SelBuf S0, S1; u32x4 R0[16], R1[16]; f32x4 wa0, wb0, wc0, wd0, wa1, wb1, wc1, wd1; float ha0, hb0, ha1, hb1;
    load_sel(S0, P, t0, q); load_sel(S1, P, t0 + 1, q);
    PE_ROWS(R0, S0, EV, eoff); PE_VMETA(wa0, wb0, wc0, wd0, ha0, hb0, t0);
#pragma unroll 1
    for (int i = 0; i < CHUNK; i += 2) {
        const int t = t0 + i;
        PE_ROWS(R1, S1, EV, eoff); PE_VMETA(wa1, wb1, wc1, wd1, ha1, hb1, t + 1);
        if (i + 2 < CHUNK) load_sel(S0, P, t + 2, q);
        v_compute(P, R0, wa0, wb0, wc0, wd0, ha0, hb0, t, s, lane);
        if (i + 2 < CHUNK) { PE_ROWS(R0, S0, EV, eoff); PE_VMETA(wa0, wb0, wc0, wd0, ha0, hb0, t + 2); }
        if (i + 3 < CHUNK) load_sel(S1, P, t + 3, q);
        v_compute(P, R1, wa1, wb1, wc1, wd1, ha1, hb1, t + 1, s, lane);
    }
}
__device__ __forceinline__ void phase_b(const Ptrs& P, unsigned* ctl, int xcc, int lane, int qoff = 0) {
    for (int si = 0; si < 8; ++si) { const int s = (xcc + si) & 7;
        for (;;) { const int ch = grab(ctl + CW_Q8B + qoff + 64 * s, lane); if (ch >= NCHUNK) break; v_chunk(P, ch * CHUNK, s, lane); } }
}
__device__ __forceinline__ void phase_c(const Ptrs& P, int gw, int NGW, int lane) {
    const float* SS = (const float*)(P.ws + WS_SS);
    for (int t = gw; t < NTOK; t += NGW) {
        const f32x4 sa = *(const f32x4*)(SS + t * 8), sb = *(const f32x4*)(SS + t * 8 + 4);
        const float rstd = rsqrtf((((sa.x + sa.y) + (sa.z + sa.w)) + ((sb.x + sb.y) + (sb.z + sb.w))) * (1.f / DM) + EPS);
        f32x4* o = (f32x4*)(P.out + (size_t)t * DM) + lane; const f32x4* fw = (const f32x4*)P.final_norm_w + lane;
#pragma unroll
        for (int j = 0; j < 4; ++j) o[64 * j] = o[64 * j] * rstd * fw[64 * j];
    }
}
}

struct Args { Ptrs P; int ph_lo, ph_hi, bar_region, pad; };
constexpr int N_PHASES = 9;

__global__ void __launch_bounds__(NWAVES * 64, 2) mk_fwd(Args args) {
    extern __shared__ __attribute__((aligned(16))) unsigned char lds[];
    LAS unsigned char* L = (LAS unsigned char*)lds;
    volatile LAS unsigned* MISC = (volatile LAS unsigned*)(L + MISC_OFF);
    const Ptrs& P = args.P;
    const int tid = threadIdx.x, lane = tid & 63, wave = __builtin_amdgcn_readfirstlane(tid >> 6);
    const int G = gridDim.x, bx = blockIdx.x, vcu = (G % 8 == 0) ? (bx % 8) * (G / 8) + bx / 8 : bx;
    const int gw = vcu * NWAVES + wave, NGW = G * NWAVES;
    unsigned char* ws = P.ws;
    unsigned* ctl = (unsigned*)(ws + WS_CTL);
    for (int u = tid; u < (LDS_BYTES - LDSCTL_OFF) / 4; u += NWAVES * 64) ((LAS unsigned*)(L + LDSCTL_OFF))[u] = 0u;
    __syncthreads();
    const int lo = args.ph_lo, hi = args.ph_hi;
    const bool multi = (hi - lo) > 1;
    unsigned* barw = ctl + CW_BAR + args.bar_region * XCD_BAR_WORDS;
    XcdBarrier bar; bar.bar = barw; bar.x = 0; bar.st = nullptr;
    if (multi) bar = xcd_barrier_post(barw, MISC + 8);
#ifndef DUP_MASK
#define DUP_MASK 0
#endif
#ifndef REPEAT_MASK
#define REPEAT_MASK 0
#endif
#define IN(k) (lo <= (k) && (k) < hi)
#define REP(k) for (int rep_ = 0; rep_ < 1 + ((REPEAT_MASK >> (k)) & 1); ++rep_)
#define SEAM(k) do { if (IN(k) && IN((k) + 1)) xcd_barrier(bar); } while (0)

    if (IN(0)) REP(0) { p0_prologue(P, gw, NGW, lane, (LAS float*)L + wave * (64 * 33)); SEAM(0); }
    if (IN(1)) {
        pg8::Gemm g{(const bf16*)(ws + WS_XN), (const bf16*)(ws + WS_WIN), NTOK, INW, DM}; pg8::StaticOrder S; S.init(NTOK, INW, G, bx);
        pg8::EpiInProj E{ws, (bf16*)P.out, (const float*)(ws + WS_ROPE), (const float*)(ws + WS_ROPE) + SEQ * 32};
        pg8::gemm_phase<pg8::EpiInProj, pg8::StaticOrder, true, true>(L, g, S, E);
        SEAM(1);
    }
#if (DUP_MASK >> 1) & 1
    if (IN(1)) {
        pg8::Gemm g{(const bf16*)(ws + WS_XN), (const bf16*)(ws + WS_WIN), NTOK, INW, DM}; pg8::StaticOrder S; S.init(NTOK, INW, G, bx);
        pg8::EpiInProj E{ws, (bf16*)P.out, (const float*)(ws + WS_ROPE), (const float*)(ws + WS_ROPE) + SEQ * 32};
        pg8::gemm_phase<pg8::EpiInProj, pg8::StaticOrder, true, true>(L, g, S, E);
        SEAM(1);
    }
#endif
    if (IN(2)) REP(2) { conv_rows(P, gw, NGW, lane); att::attn_phase(P, L, vcu, G, wave, lane); SEAM(2); }
    if (IN(3)) {
        { pg8::Gemm g{(const bf16*)(ws + WS_ATTN), (const bf16*)(ws + WS_WPA), NTOK, DM, AW}; pg8::StaticOrder S; S.init(NTOK, DM, G, bx);
          pg8::EpiGate<0> E{(const bf16*)P.out, nullptr, (bf16*)(ws + WS_TMP)};
          pg8::gemm_phase<pg8::EpiGate<0>, pg8::StaticOrder, true, true>(L, g, S, E); }
        asm volatile("s_waitcnt vmcnt(0)" ::: "memory"); __syncthreads();
        { pg8::Gemm g{(const bf16*)(ws + WS_CF), (const bf16*)(ws + WS_WPB), NTOK, DM, CW}; pg8::StaticOrder S; S.init(NTOK, DM, G, bx);
          pg8::EpiGate<1> E{(const bf16*)P.out + (size_t)NTOK * DM, (const bf16*)(ws + WS_TMP), (bf16*)(ws + WS_MG)};
          pg8::gemm_phase<pg8::EpiGate<1>, pg8::StaticOrder, true, true>(L, g, S, E); }
        SEAM(3);
    }
#if (DUP_MASK >> 3) & 1
    if (IN(3)) {
        { pg8::Gemm g{(const bf16*)(ws + WS_ATTN), (const bf16*)(ws + WS_WPA), NTOK, DM, AW}; pg8::StaticOrder S; S.init(NTOK, DM, G, bx);
          pg8::EpiGate<0> E{(const bf16*)P.out, nullptr, (bf16*)(ws + WS_TMP)};
          pg8::gemm_phase<pg8::EpiGate<0>, pg8::StaticOrder, true, true>(L, g, S, E); }
        asm volatile("s_waitcnt vmcnt(0)" ::: "memory"); __syncthreads();
        { pg8::Gemm g{(const bf16*)(ws + WS_CF), (const bf16*)(ws + WS_WPB), NTOK, DM, CW}; pg8::StaticOrder S; S.init(NTOK, DM, G, bx);
          pg8::EpiGate<1> E{(const bf16*)P.out + (size_t)NTOK * DM, (const bf16*)(ws + WS_TMP), (bf16*)(ws + WS_MG)};
          pg8::gemm_phase<pg8::EpiGate<1>, pg8::StaticOrder, true, true>(L, g, S, E); }
        SEAM(3);
    }
#endif
    if (IN(4)) {
        pg8::Gemm g{(const bf16*)(ws + WS_MG), (const bf16*)(ws + WS_WO), NTOK, DM, DM}; pg8::StaticOrder S; S.init(NTOK, DM, G, bx);
        pg8::EpiResid E{P.x, (float*)(ws + WS_H)};
        pg8::gemm_phase<pg8::EpiResid, pg8::StaticOrder, true, true>(L, g, S, E);
        SEAM(4);
    }
#if (DUP_MASK >> 4) & 1
    if (IN(4)) {
        pg8::Gemm g{(const bf16*)(ws + WS_MG), (const bf16*)(ws + WS_WO), NTOK, DM, DM}; pg8::StaticOrder S; S.init(NTOK, DM, G, bx);
        pg8::EpiResid E{P.x, (float*)(ws + WS_H)};
        pg8::gemm_phase<pg8::EpiResid, pg8::StaticOrder, true, true>(L, g, S, E);
        SEAM(4);
    }
#endif
    if (IN(5)) REP(5) { p5_hn(P, gw, NGW, lane); SEAM(5); }
    if (IN(6)) {
        pg8::Gemm g{(const bf16*)(ws + WS_HN), (const bf16*)(ws + WS_WQ), NTOK, QPW, DM}; pg8::StaticOrder S; S.init(NTOK, QPW, G, bx);
        pg8::EpiPlainBf16 E{(bf16*)(ws + WS_QP), QPW};
        pg8::gemm_phase<pg8::EpiPlainBf16, pg8::StaticOrder, true, true>(L, g, S, E);
        SEAM(6);
    }
#if (DUP_MASK >> 6) & 1
    if (IN(6)) {
        pg8::Gemm g{(const bf16*)(ws + WS_HN), (const bf16*)(ws + WS_WQ), NTOK, QPW, DM}; pg8::StaticOrder S; S.init(NTOK, QPW, G, bx);
        pg8::EpiPlainBf16 E{(bf16*)(ws + WS_QP), QPW};
        pg8::gemm_phase<pg8::EpiPlainBf16, pg8::StaticOrder, true, true>(L, g, S, E);
        SEAM(6);
    }
#endif
    if (IN(7)) REP(7) { tk::topk_phase(P, L, vcu, G, wave, lane, tid); SEAM(7); }
    if (IN(8)) {
        const int xcc = (int)(xb_xcc_id() & 7u);
        pe::phase_a(P, ctl, xcc, lane); xcd_barrier(bar);
#if (DUP_MASK >> 9) & 1
        pe::phase_a(P, ctl, xcc, lane, 1024); xcd_barrier(bar);
#endif
        pe::phase_a2(P, (vcu * NWAVES + wave) * 64 + lane, NGW * 64); xcd_barrier(bar);
#if (DUP_MASK >> 11) & 1
        pe::phase_a2(P, (vcu * NWAVES + wave) * 64 + lane, NGW * 64); xcd_barrier(bar);
#endif
        pe::phase_b(P, ctl, xcc, lane); xcd_barrier(bar);
#if (DUP_MASK >> 10) & 1
        pe::phase_b(P, ctl, xcc, lane, 1024); xcd_barrier(bar);
#endif
        pe::phase_c(P, gw, NGW, lane);
#if (DUP_MASK >> 12) & 1
        xcd_barrier(bar); pe::phase_c2(P, gw, NGW, lane);
#endif
    }
#undef IN
#undef SEAM
}
static int g_grid = 0;
static void mk_launch(const Ptrs& P, int lo, int hi, int region, hipStream_t stream) {
    Args a{}; a.P = P; a.ph_lo = lo; a.ph_hi = hi; a.bar_region = region;
    void* params[] = {&a};
    hipError_t e = hipLaunchCooperativeKernel((const void*)mk_fwd, dim3(g_grid), dim3(NWAVES * 64), params, LDS_BYTES, stream);
    if (e != hipSuccess) fprintf(stderr, "mk launch failed: %s\n", hipGetErrorString(e));
}
extern "C" void kernel_launch(void* const* d_in, const int* in_sizes, int n_in, void* d_out, int out_size, void* d_ws, size_t ws_size, hipStream_t stream) {
    Ptrs P{};
    const float** pp = (const float**)&P;
    for (int i = 0; i < 18; ++i) pp[i] = (const float*)d_in[i];
    P.out = (float*)d_out; P.ws = (unsigned char*)d_ws;
    if (g_grid == 0) {
        (void)hipFuncSetAttribute((const void*)nk_prep, hipFuncAttributeMaxDynamicSharedMemorySize, 8 * 64 * 33 * 4);
        (void)hipFuncSetAttribute((const void*)nk_topk, hipFuncAttributeMaxDynamicSharedMemorySize, 64 * 320 * 4);
        (void)hipFuncSetAttribute((const void*)mk_fwd, hipFuncAttributeMaxDynamicSharedMemorySize, LDS_BYTES);
        int dev = 0, cus = 0, per_cu = 0;
        (void)hipGetDevice(&dev); (void)hipDeviceGetAttribute(&cus, hipDeviceAttributeMultiprocessorCount, dev);
        (void)hipOccupancyMaxActiveBlocksPerMultiprocessor(&per_cu, (const void*)mk_fwd, NWAVES * 64, LDS_BYTES);
        if (per_cu < 1) { fprintf(stderr, "occupancy query says %d blocks/CU\n", per_cu); per_cu = 1; }
        g_grid = cus * 1;
    }
    (void)hipMemsetAsync((char*)d_ws + WS_CTL, 0, CTL_BYTES, stream);
    mk_launch(P, 0, 9, 0, stream);
}
```
